# Optimizing an MI355X kernel written in HIP

```python
import math
import jax
import jax.numpy as jnp
from jax import lax
import numpy as np

D_MODEL = 1024
BATCH = 32
SEQ = 256
DEPTH = 4
DEC_BATCH = 2
DEC_SEQ = 1024
PAST_LEN = 256

GRID_W = 64
N_HEADS = 8
N_KV = 2
HEAD_DIM = 64
GQA_G = N_HEADS // N_KV
ATT_W = N_HEADS * HEAD_DIM
KV_W = N_KV * HEAD_DIM
WINDOW = 128
BLOCK = 128
ROPE_BASE = 10000.0
LRU_W = 512
LRU_BLOCKS = 8
LRU_BD = LRU_W // LRU_BLOCKS
LRU_CONV = 4
LRU_C = 8.0
FNET_GROUPS = 4
FNET_W = 512
FNET_GD = FNET_W // FNET_GROUPS
HY_W = 512
HY_ORDER = 2
HY_CONV = 3
HY_BANDS = 16
HY_EMB = 1 + 2 * HY_BANDS
HY_HID = 64
HY_FILT = 2 * HY_ORDER * HY_W
HY_DECAY_MIN = math.log(100.0) / 1.5
HY_DECAY_MAX = math.log(100.0) / 0.3
EVEN_IN = ATT_W + 2 * KV_W + 2 * LRU_W
EVEN_OUT = ATT_W + LRU_W
ODD_IN = FNET_W + (HY_ORDER + 1) * HY_W
ODD_OUT = FNET_W + HY_W
D_FF = 4 * D_MODEL
N_MOD = 6
N_EVEN = (DEPTH + 1) // 2
N_ODD = DEPTH // 2
EPS = 1e-6
NEG = -1e30

kernel_name = 'hybrid_diffusion_prefix_step'


def _rmsnorm(x, g):
    xf = x.astype(jnp.float32)
    y = xf * lax.rsqrt(jnp.mean(xf * xf, axis=-1, keepdims=True) + EPS)
    return (y * g.astype(jnp.float32)).astype(x.dtype)


def _modulation(cvec, w, b):
    m = jax.nn.silu(cvec) @ w + b
    return jnp.split(m[:, None, :], N_MOD, axis=-1)


def _dwconv(x, w, b, left):
    width = w.shape[0]
    L = x.shape[1]
    xp = jnp.pad(x, ((0, 0), (left, width - 1 - left), (0, 0)))
    y = b
    for k in range(width):
        y = y + xp[:, k:k + L] * w[k]
    return y


def _axial_rope(x):
    L = x.shape[1]
    rows = L // GRID_W
    row = jnp.repeat(jnp.arange(rows), GRID_W).astype(jnp.float32)
    col = jnp.tile(jnp.arange(GRID_W), rows).astype(jnp.float32)
    n = HEAD_DIM // 4
    inv = ROPE_BASE ** (-jnp.arange(n, dtype=jnp.float32) / n)
    shape = (1, L) + (1,) * (x.ndim - 3) + (n,)
    xf = x.astype(jnp.float32)
    outs = []
    for a, pos in enumerate((row, col)):
        ang = (pos[:, None] * inv[None, :]).reshape(shape)
        cos, sin = jnp.cos(ang), jnp.sin(ang)
        seg = xf[..., a * 2 * n:(a + 1) * 2 * n]
        x1, x2 = seg[..., :n], seg[..., n:]
        outs += [x1 * cos - x2 * sin, x2 * cos + x1 * sin]
    return jnp.concatenate(outs, axis=-1).astype(x.dtype)


def _sink_attend(q, k, v, sink, mask):
    s = jnp.einsum('bqhgd,bkhd->bhgqk', q, k).astype(jnp.float32) * (HEAD_DIM ** -0.5)
    if mask is not None:
        s = jnp.where(mask, s, NEG)
    sk = jnp.broadcast_to(sink.astype(jnp.float32)[None, :, :, None, None], s.shape[:-1] + (1,))
    p = jax.nn.softmax(jnp.concatenate([s, sk], axis=-1), axis=-1)[..., :-1]
    return jnp.einsum('bhgqk,bkhd->bqhgd', p.astype(v.dtype), v)


def _ctx_attention(q, k, v, sink):
    B, L = q.shape[:2]
    nb = L // BLOCK
    qb = q.reshape(B, nb, BLOCK, N_KV, GQA_G, HEAD_DIM).swapaxes(0, 1)
    o = lax.map(lambda qi: _sink_attend(qi, k, v, sink, None), qb)
    return o.swapaxes(0, 1).reshape(B, L, N_KV, GQA_G, HEAD_DIM)


def _lat_attention(q, k, v, k_ctx, v_ctx, sink):
    B, L = q.shape[:2]
    nb = L // BLOCK
    lc = k_ctx.shape[1]
    qb = q.reshape(B, nb, BLOCK, N_KV, GQA_G, HEAD_DIM).swapaxes(0, 1)
    pad = ((0, 0), (BLOCK, BLOCK), (0, 0), (0, 0))
    kp, vp = jnp.pad(k, pad), jnp.pad(v, pad)
    k_ctx = k_ctx.astype(k.dtype)
    v_ctx = v_ctx.astype(v.dtype)
    rel = jnp.arange(3 * BLOCK)[None, :] - BLOCK - jnp.arange(BLOCK)[:, None]
    win_ok = jnp.abs(rel) <= WINDOW
    ctx_ok = jnp.ones((BLOCK, lc), dtype=bool)

    def one(args):
        qi, bi = args
        start = bi * BLOCK
        kw = lax.dynamic_slice_in_dim(kp, start, 3 * BLOCK, axis=1)
        vw = lax.dynamic_slice_in_dim(vp, start, 3 * BLOCK, axis=1)
        kpos = start - BLOCK + jnp.arange(3 * BLOCK)
        in_seq = (kpos >= 0) & (kpos < L)
        mask = jnp.concatenate([win_ok & in_seq[None, :], ctx_ok], axis=1)
        return _sink_attend(qi, jnp.concatenate([kw, k_ctx], axis=1),
                            jnp.concatenate([vw, v_ctx], axis=1), sink, mask)

    o = lax.map(one, (qb, jnp.arange(nb)))
    return o.swapaxes(0, 1).reshape(B, L, N_KV, GQA_G, HEAD_DIM)


def _combine(e1, e2):
    a1, b1 = e1
    a2, b2 = e2
    return a1 * a2, a2 * b1 + b2


def _rglru_dir(x, h0, w_r, b_r, w_i, b_i, lam, reverse):
    B, L, _ = x.shape
    xb = x.reshape(B, L, LRU_BLOCKS, LRU_BD)
    r = jax.nn.sigmoid(jnp.einsum('blhi,hij->blhj', xb, w_r.astype(jnp.float32)).reshape(B, L, LRU_W) + b_r)
    gi = jax.nn.sigmoid(jnp.einsum('blhi,hij->blhj', xb, w_i.astype(jnp.float32)).reshape(B, L, LRU_W) + b_i)
    log_a = -LRU_C * r * jax.nn.softplus(-lam.astype(jnp.float32))
    a = jnp.exp(log_a)
    u = jnp.sqrt(-jnp.expm1(2.0 * log_a)) * (gi * x)
    if reverse:
        a, u = a[:, ::-1], u[:, ::-1]
    A, S = lax.associative_scan(_combine, (a, u), axis=1)
    h = A * h0.astype(jnp.float32)[:, None, :] + S
    return h[:, ::-1] if reverse else h


def _lru_branch(xr, g, h0f, h0b, conv_w, conv_b, w_r, b_r, w_i, b_i, lam):
    xc = _dwconv(xr, conv_w, conv_b, LRU_CONV // 2).astype(jnp.float32)
    hf = _rglru_dir(xc, h0f, w_r[0], b_r[0], w_i[0], b_i[0], lam[0], False)
    hb = _rglru_dir(xc, h0b, w_r[1], b_r[1], w_i[1], b_i[1], lam[1], True)
    y = (hf + hb) * jax.nn.gelu(g.astype(jnp.float32))
    return y.astype(xr.dtype), hf[:, -1], hb[:, 0]


def _even_mixer(h, k_ctx, v_ctx, h0f, h0b, w_in, w_out, sink, conv_w, conv_b, w_r, b_r, w_i, b_i, lam):
    B, L, _ = h.shape
    p = h @ w_in
    o1, o2, o3, o4 = ATT_W, ATT_W + KV_W, ATT_W + 2 * KV_W, ATT_W + 2 * KV_W + LRU_W
    q = p[..., :o1].reshape(B, L, N_KV, GQA_G, HEAD_DIM)
    k = p[..., o1:o2].reshape(B, L, N_KV, HEAD_DIM)
    v = p[..., o2:o3].reshape(B, L, N_KV, HEAD_DIM)
    xr, g = p[..., o3:o4], p[..., o4:]
    sink = sink.reshape(N_KV, GQA_G)
    if k_ctx is None:
        att = _ctx_attention(q, k, v, sink)
        h0f = h0b = jnp.zeros((B, LRU_W), jnp.float32)
    else:
        att = _lat_attention(_axial_rope(q), _axial_rope(k), v, k_ctx, v_ctx, sink)
    y_lru, sf, sb = _lru_branch(xr, g, h0f, h0b, conv_w, conv_b, w_r, b_r, w_i, b_i, lam)
    out = jnp.concatenate([att.reshape(B, L, ATT_W), y_lru], axis=-1) @ w_out
    return out, k, v, sf, sb


def _hyena_filters(L, w1, b1, w2, b2, w3, freq, log_decay):
    t = jnp.arange(L, dtype=jnp.float32)
    tn = t / L
    bands = jnp.linspace(1e-4, HY_BANDS - 1, HY_BANDS, dtype=jnp.float32)
    w = (2.0 * math.pi / L) * t
    z = jnp.concatenate([tn[:, None], jnp.cos(w[:, None] * bands), -jnp.sin(w[:, None] * bands)], axis=-1)
    hid = jnp.sin(freq[0].astype(jnp.float32) * (z @ w1.astype(jnp.float32) + b1))
    hid = jnp.sin(freq[1].astype(jnp.float32) * (hid @ w2.astype(jnp.float32) + b2))
    filt = (hid @ w3.astype(jnp.float32)) * jnp.exp(-tn[:, None] * jnp.exp(log_decay.astype(jnp.float32)))
    filt = filt.reshape(L, 2, HY_ORDER, HY_W)
    two = jnp.concatenate([filt[:, 0], filt[::-1, 1]], axis=0)
    two = two * lax.rsqrt(jnp.sum(two * two, axis=0, keepdims=True) + EPS)
    return jnp.fft.rfft(two, axis=0)


def _fft_conv(u, kf):
    L = u.shape[1]
    U = jnp.fft.rfft(u, n=2 * L, axis=1)
    return jnp.fft.irfft(U * kf[None], n=2 * L, axis=1)[:, :L]


def _odd_mixer(h, w_in, w_out, conv_w, conv_b, w1, b1, w2, b2, w3, freq, log_decay, hy_bias):
    B, L, _ = h.shape
    p = h @ w_in
    f = p[..., :FNET_W].astype(jnp.float32).reshape(B, L, FNET_GROUPS, FNET_GD)
    yf = jnp.fft.fft2(f, axes=(1, 3), norm='ortho').real.reshape(B, L, FNET_W)
    u = _dwconv(p[..., FNET_W:], conv_w, conv_b, HY_CONV // 2).astype(jnp.float32)
    v, x1, x2 = jnp.split(u, HY_ORDER + 1, axis=-1)
    kf = _hyena_filters(L, w1, b1, w2, b2, w3, freq, log_decay)
    z = v
    for n, gate in enumerate((x1, x2)):
        z = gate * (_fft_conv(z, kf[:, n]) + hy_bias[n].astype(jnp.float32) * z)
    return jnp.concatenate([yf, z], axis=-1).astype(h.dtype) @ w_out


def _mlp(h, w1, w2):
    return jnp.square(jax.nn.relu(h @ w1)) @ w2


def setup_inputs(seed: int = 0) -> dict:
    key = jax.random.key(seed)
    ks = iter(jax.random.split(key, 40))

    def nrm(shape, s):
        return jax.random.normal(next(ks), shape, jnp.float32) * s

    lam_u = jax.random.uniform(next(ks), (N_EVEN, 2, LRU_W), jnp.float32, 0.9, 0.999)
    lam_s = lam_u ** (1.0 / LRU_C)
    decay0 = jnp.log(jnp.linspace(HY_DECAY_MIN, HY_DECAY_MAX, HY_FILT, dtype=jnp.float32))
    return {
        'x_prompt': nrm((BATCH, SEQ, D_MODEL), 1.0),
        'x_sample': nrm((DEC_BATCH, DEC_SEQ, D_MODEL), 1.0),
        'c': nrm((DEC_BATCH, D_MODEL), 1.0),
        'cache_k': nrm((DEC_BATCH, N_EVEN, PAST_LEN, N_KV, HEAD_DIM), 1.0),
        'cache_v': nrm((DEC_BATCH, N_EVEN, PAST_LEN, N_KV, HEAD_DIM), 1.0),
        'state_lru': nrm((DEC_BATCH, N_EVEN, 2, LRU_W), 0.5),
        'c_ctx': nrm((D_MODEL,), 1.0),
        'mod_w': nrm((DEPTH, D_MODEL, N_MOD * D_MODEL), 0.5 * D_MODEL ** -0.5),
        'mod_b': nrm((DEPTH, N_MOD * D_MODEL), 0.02),
        'norm_mix': 1.0 + nrm((DEPTH, D_MODEL), 0.02),
        'norm_mlp': 1.0 + nrm((DEPTH, D_MODEL), 0.02),
        'norm_final': 1.0 + nrm((D_MODEL,), 0.02),
        'mlp_w1': nrm((DEPTH, D_MODEL, D_FF), D_MODEL ** -0.5),
        'mlp_w2': nrm((DEPTH, D_FF, D_MODEL), D_FF ** -0.5),
        'ev_w_in': nrm((N_EVEN, D_MODEL, EVEN_IN), D_MODEL ** -0.5),
        'ev_w_out': nrm((N_EVEN, EVEN_OUT, D_MODEL), EVEN_OUT ** -0.5),
        'attn_sink': nrm((N_EVEN, N_HEADS), 0.5),
        'lru_conv_w': nrm((N_EVEN, LRU_CONV, LRU_W), LRU_CONV ** -0.5),
        'lru_conv_b': nrm((N_EVEN, LRU_W), 0.02),
        'lru_w_r': nrm((N_EVEN, 2, LRU_BLOCKS, LRU_BD, LRU_BD), LRU_BD ** -0.5),
        'lru_b_r': nrm((N_EVEN, 2, LRU_W), 0.02),
        'lru_w_i': nrm((N_EVEN, 2, LRU_BLOCKS, LRU_BD, LRU_BD), LRU_BD ** -0.5),
        'lru_b_i': nrm((N_EVEN, 2, LRU_W), 0.02),
        'lru_lambda': jnp.log(lam_s) - jnp.log1p(-lam_s),
        'od_w_in': nrm((N_ODD, D_MODEL, ODD_IN), D_MODEL ** -0.5),
        'od_w_out': nrm((N_ODD, ODD_OUT, D_MODEL), ODD_OUT ** -0.5),
        'hy_conv_w': nrm((N_ODD, HY_CONV, (HY_ORDER + 1) * HY_W), HY_CONV ** -0.5),
        'hy_conv_b': nrm((N_ODD, (HY_ORDER + 1) * HY_W), 0.02),
        'hy_w1': nrm((N_ODD, HY_EMB, HY_HID), HY_EMB ** -0.5),
        'hy_b1': nrm((N_ODD, HY_HID), 0.02),
        'hy_w2': nrm((N_ODD, HY_HID, HY_HID), HY_HID ** -0.5),
        'hy_b2': nrm((N_ODD, HY_HID), 0.02),
        'hy_w3': nrm((N_ODD, HY_HID, HY_FILT), HY_HID ** -0.5),
        'hy_freq': 1.0 + nrm((N_ODD, 2, HY_HID), 0.02),
        'hy_log_decay': decay0[None, :] + nrm((N_ODD, HY_FILT), 0.02),
        'hy_bias': nrm((N_ODD, HY_ORDER, HY_W), 0.1),
    }


def reference(x_prompt, x_sample, c, cache_k, cache_v, state_lru, c_ctx, mod_w, mod_b, norm_mix, norm_mlp,
              norm_final, mlp_w1, mlp_w2, ev_w_in, ev_w_out, attn_sink, lru_conv_w, lru_conv_b, lru_w_r,
              lru_b_r, lru_w_i, lru_b_i, lru_lambda, od_w_in, od_w_out, hy_conv_w, hy_conv_b, hy_w1, hy_b1,
              hy_w2, hy_b2, hy_w3, hy_freq, hy_log_decay, hy_bias):
    xp, xs = x_prompt, x_sample
    k_list, v_list, s_list = [], [], []
    for l in range(DEPTH):
        mp = _modulation(c_ctx[None, :], mod_w[l], mod_b[l])
        ms = _modulation(c, mod_w[l], mod_b[l])
        hp = _rmsnorm(xp, norm_mix[l]) * (1.0 + mp[1]) + mp[0]
        hs = _rmsnorm(xs, norm_mix[l]) * (1.0 + ms[1]) + ms[0]
        j = l // 2
        if l % 2 == 0:
            ev = (ev_w_in[j], ev_w_out[j], attn_sink[j], lru_conv_w[j], lru_conv_b[j], lru_w_r[j],
                  lru_b_r[j], lru_w_i[j], lru_b_i[j], lru_lambda[j])
            op, kc, vc, sf, sb = _even_mixer(hp, None, None, None, None, *ev)
            os_ = _even_mixer(hs, cache_k[:, j], cache_v[:, j], state_lru[:, j, 0], state_lru[:, j, 1], *ev)[0]
            k_list.append(kc)
            v_list.append(vc)
            s_list.append(jnp.stack([sf, sb], axis=1))
        else:
            od = (od_w_in[j], od_w_out[j], hy_conv_w[j], hy_conv_b[j], hy_w1[j], hy_b1[j], hy_w2[j],
                  hy_b2[j], hy_w3[j], hy_freq[j], hy_log_decay[j], hy_bias[j])
            op = _odd_mixer(hp, *od)
            os_ = _odd_mixer(hs, *od)
        xp = xp + mp[2] * op
        xs = xs + ms[2] * os_
        hp = _rmsnorm(xp, norm_mlp[l]) * (1.0 + mp[4]) + mp[3]
        hs = _rmsnorm(xs, norm_mlp[l]) * (1.0 + ms[4]) + ms[3]
        xp = xp + mp[5] * _mlp(hp, mlp_w1[l], mlp_w2[l])
        xs = xs + ms[5] * _mlp(hs, mlp_w1[l], mlp_w2[l])
    y_prompt = _rmsnorm(xp, norm_final)
    y_sample = _rmsnorm(xs, norm_final)
    k_state = jnp.stack(k_list, axis=1)
    v_state = jnp.stack(v_list, axis=1)
    lru_state = jnp.stack(s_list, axis=1).astype(x_prompt.dtype)
    return (y_prompt, y_sample, k_state, v_state, lru_state)
```

```cpp
#include <hip/hip_runtime.h>
#include <hip/hip_cooperative_groups.h>
#include <cstdio>
#include <cstdint>
namespace cg = cooperative_groups;

typedef unsigned short bf16_t;
typedef short bf16x8 __attribute__((ext_vector_type(8)));
typedef short s16x4 __attribute__((ext_vector_type(4)));
typedef float f32x4 __attribute__((ext_vector_type(4)));
typedef unsigned u32x4 __attribute__((ext_vector_type(4)));
#define DEV __device__ __forceinline__
__device__ __forceinline__ int tid_launder() { int t = (int)threadIdx.x; asm volatile("" : "+v"(t)); return t; }
#define TIDX tid_launder()

#ifndef PROBE_MASK
#define PROBE_MASK 0
#endif
#define REP(x) ((((PROBE_MASK) >> (x)) & 1) + 1)
#ifndef N_LAUNCH_SPLIT
#define N_LAUNCH_SPLIT 0
#endif

constexpr int MROWS = 10240, MCTX = 8192, DM = 1024;
constexpr int LDS_BYTES = 72 * 1024;
constexpr int NPHASE = 25;

struct Params { const float* in[36]; float* out; unsigned char* ws; };

constexpr size_t MiB = 1ull << 20;
constexpr size_t OFF_WTIN  = 0;
constexpr size_t OFF_WTOUT = OFF_WTIN + 16 * MiB;
constexpr size_t OFF_WT1   = OFF_WTOUT + 8 * MiB;
constexpr size_t OFF_WT2   = OFF_WT1 + 32 * MiB;
constexpr size_t OFF_MOD   = OFF_WT2 + 32 * MiB;
constexpr size_t OFF_SWIN  = OFF_MOD + 1 * MiB;
constexpr size_t OFF_SW1   = OFF_SWIN + 256 * 1024;
constexpr size_t OFF_CS128 = OFF_SW1 + 256 * 1024;
constexpr size_t OFF_CSL256 = OFF_CS128 + 65536;
constexpr size_t OFF_ROPE  = OFF_CSL256 + 262144;
constexpr size_t OFF_HID   = OFF_ROPE + 8192;
constexpr size_t OFF_CSL1024 = OFF_HID + 655360 + 32768;
constexpr size_t OFF_TF    = OFF_CSL1024 + 4 * MiB;
constexpr size_t OFF_X     = OFF_TF + 20 * MiB;
constexpr size_t OFF_XG    = OFF_X + 40 * MiB;
constexpr size_t OFF_SSQ   = OFF_XG + 20 * MiB;
constexpr size_t OFF_P     = OFF_SSQ + 6 * MiB;
constexpr size_t OFF_HU    = OFF_P + 80 * MiB;
constexpr size_t OFF_PF    = OFF_HU + 60 * MiB;
constexpr size_t OFF_MIX   = OFF_PF + 10 * MiB;
constexpr size_t OFF_FT    = OFF_MIX + 20 * MiB;
constexpr size_t OFF_CTL   = OFF_FT + 20 * MiB;
constexpr size_t CTL_BYTES = 16384 + 131072;
constexpr size_t WS_END    = OFF_CTL + CTL_BYTES;

constexpr size_t OUT_YS = 8388608, OUT_K = 10485760, OUT_V = 12582912, OUT_LRU = 14680064;

DEV bf16_t f2bf(float f) { unsigned u = __float_as_uint(f); u += 0x7fffu + ((u >> 16) & 1u); return (bf16_t)(u >> 16); }
DEV unsigned pack2(float a, float b) { return (unsigned)f2bf(a) | ((unsigned)f2bf(b) << 16); }
DEV int vec_of_row(int row) { return row < MCTX ? 0 : 1 + ((row - MCTX) >> 10); }
DEV float sigmoidf_(float x) { return 1.0f / (1.0f + __expf(-x)); }


DEV int wq_next(unsigned* ctr, unsigned char* lds) {
    volatile int* slot = (volatile int*)(lds + LDS_BYTES - 32);
    __syncthreads();
    if (threadIdx.x == 0) { const unsigned x = blockIdx.x & 7u; *slot = (int)(__hip_atomic_fetch_add(ctr + x * 64, 1u, __ATOMIC_RELAXED, __HIP_MEMORY_SCOPE_AGENT) * 8u + x); }
    __syncthreads();
    return *slot;
}
template <int NB>
DEV void g_load(u32x4 (&ra)[4], u32x4 (&rb)[NB], const u32x4* Ag, const u32x4* Bg, size_t sa, size_t sb, int kt) {
#pragma unroll
    for (int i = 0; i < 4; ++i) ra[i] = Ag[i * sa + (size_t)kt * 8];
#pragma unroll
    for (int i = 0; i < NB; ++i) rb[i] = Bg[i * sb + (size_t)kt * 8];
}
template <int NB>
DEV void g_write(const u32x4 (&ra)[4], const u32x4 (&rb)[NB], unsigned char* base) {
#pragma unroll
    for (int i = 0; i < 4; ++i) *(u32x4*)(base + i * 4096) = ra[i];
#pragma unroll
    for (int i = 0; i < NB; ++i) *(u32x4*)(base + 16384 + i * 4096) = rb[i];
}
template <int MI, bool TRANS>
DEV void g_compute(f32x4 (&acc)[MI][4], const unsigned char* pa, const unsigned char* pb, int fq, int sw) {
#pragma unroll
    for (int ks = 0; ks < 2; ++ks) {
        bf16x8 af[MI], bfr[4];
        const int ch = ((ks * 4 + fq) ^ sw) << 4;
#pragma unroll
        for (int mi = 0; mi < MI; ++mi) af[mi] = *(const bf16x8*)(pa + mi * 2048 + ch);
#pragma unroll
        for (int ni = 0; ni < 4; ++ni) bfr[ni] = *(const bf16x8*)(pb + ni * 2048 + ch);
#pragma unroll
        for (int mi = 0; mi < MI; ++mi)
#pragma unroll
            for (int ni = 0; ni < 4; ++ni) acc[mi][ni] = TRANS ? __builtin_amdgcn_mfma_f32_16x16x32_bf16(af[mi], bfr[ni], acc[mi][ni], 0, 0, 0)
                                                               : __builtin_amdgcn_mfma_f32_16x16x32_bf16(bfr[ni], af[mi], acc[mi][ni], 0, 0, 0);
    }
}
template <int BN, class Epi, bool TRANS = false>
DEV void gemm_tile(const bf16_t* __restrict__ A, int lda, const bf16_t* __restrict__ Bt, int ldb, int K, int m0, int n0,
                   unsigned char* lds, const Epi& epi) {
    constexpr int MI = BN == 128 ? 4 : 2, NB = BN / 32;
    const int tid = TIDX, lane = tid & 63, wid = tid >> 6, fr = lane & 15, fq = lane >> 4;
    const int wr = BN == 128 ? (wid >> 1) : wid, wc = BN == 128 ? (wid & 1) : 0;
    const int rbase = wr * (MI * 16);
    f32x4 acc[MI][4];
#pragma unroll
    for (int i = 0; i < MI; ++i)
#pragma unroll
        for (int j = 0; j < 4; ++j) acc[i][j] = (f32x4){0.f, 0.f, 0.f, 0.f};
    const int lrow = tid >> 3, lc = tid & 7;
    const u32x4* Ag = (const u32x4*)(A + (size_t)(m0 + lrow) * lda + lc * 8);
    const u32x4* Bg = (const u32x4*)(Bt + (size_t)(n0 + lrow) * ldb + lc * 8);
    const size_t sa = (size_t)4 * lda, sb = (size_t)4 * ldb;
    const int woff = lrow * 128 + ((lc ^ ((lrow >> 1) & 7)) << 4);
    const int sw = (fr >> 1) & 7;
    const int aoff = (rbase + fr) * 128, boff = 16384 + (wc * 64 + fr) * 128;
    u32x4 ra0[4], rb0[NB], ra1[4], rb1[NB];
    const int nk = K >> 6;
    g_load<NB>(ra0, rb0, Ag, Bg, sa, sb, 0);
    g_write<NB>(ra0, rb0, lds + woff);
    g_load<NB>(ra0, rb0, Ag, Bg, sa, sb, 1);
    __syncthreads();
    for (int kt = 0; kt < nk; kt += 2) {
        g_load<NB>(ra1, rb1, Ag, Bg, sa, sb, kt + 2 < nk ? kt + 2 : nk - 1);
        g_compute<MI, TRANS>(acc, lds + aoff, lds + boff, fq, sw);
        g_write<NB>(ra0, rb0, lds + 32768 + woff);
        __syncthreads();
        g_load<NB>(ra0, rb0, Ag, Bg, sa, sb, kt + 3 < nk ? kt + 3 : nk - 1);
        g_compute<MI, TRANS>(acc, lds + 32768 + aoff, lds + 32768 + boff, fq, sw);
        g_write<NB>(ra1, rb1, lds + woff);
        __syncthreads();
    }
    epi.template operator()<MI>(acc, m0, n0, rbase, wc, fr, fq, lds);
}


template <int BN>
struct GStream {
    static constexpr int MI = BN == 128 ? 4 : 2, NB = BN / 32;
    const bf16_t* A; const bf16_t* Bt; int lda, ldb, K; const float* ssq; unsigned char* lds;
    int tid, fr, fq, rbase, wc, woff, aoff, boff, sw, lrow, lc;
    u32x4 ra0[4], rb0[NB], ra1[4], rb1[NB];
    float pr[16];
    DEV void init(const bf16_t* A_, int lda_, const bf16_t* Bt_, int ldb_, int K_, const float* ssq_, unsigned char* lds_) {
        A = A_; Bt = Bt_; lda = lda_; ldb = ldb_; K = K_; ssq = ssq_; lds = lds_;
        tid = TIDX; const int lane = tid & 63, wid = tid >> 6; fr = lane & 15; fq = lane >> 4;
        const int wr = BN == 128 ? (wid >> 1) : wid; wc = BN == 128 ? (wid & 1) : 0;
        rbase = wr * (MI * 16);
        lrow = tid >> 3; lc = tid & 7;
        woff = lrow * 128 + ((lc ^ ((lrow >> 1) & 7)) << 4);
        sw = (fr >> 1) & 7;
        aoff = (rbase + fr) * 128; boff = 16384 + (wc * 64 + fr) * 128;
#pragma unroll
        for (int i = 0; i < 16; ++i) pr[i] = 0.f;
    }
    DEV void prefetch(int m0, int n0) {
        const u32x4* Ag = (const u32x4*)(A + (size_t)(m0 + lrow) * lda + lc * 8);
        const u32x4* Bg = (const u32x4*)(Bt + (size_t)(n0 + lrow) * ldb + lc * 8);
        const size_t sa = (size_t)4 * lda, sb = (size_t)4 * ldb;
        g_load<NB>(ra0, rb0, Ag, Bg, sa, sb, 0);
    }
    DEV void sched_pattern() {
        __builtin_amdgcn_sched_group_barrier(0x100, 2 * (MI + 4), 0);
#pragma unroll
        for (int i = 0; i < 4 + NB; ++i) {
            __builtin_amdgcn_sched_group_barrier(0x008, BN == 128 ? 4 : 2, 0);
            __builtin_amdgcn_sched_group_barrier(0x020, 1, 0);
            __builtin_amdgcn_sched_group_barrier(0x200, 1, 0);
        }
        if (BN == 64) __builtin_amdgcn_sched_group_barrier(0x008, 4, 0);
    }
    template <bool TRANS, class Epi>
    DEV void run_tile(int m0, int n0, int m0n, int n0n, const Epi& epi) {
        __syncthreads();
        g_write<NB>(ra0, rb0, lds + woff);
        if (ssq) {
            const float* q = ssq + m0 + (tid & 127);
#pragma unroll
            for (int i = 0; i < 16; ++i) pr[i] = q[(size_t)i * MROWS];
        }
        const u32x4* Ag = (const u32x4*)(A + (size_t)(m0 + lrow) * lda + lc * 8);
        const u32x4* Bg = (const u32x4*)(Bt + (size_t)(n0 + lrow) * ldb + lc * 8);
        const size_t sa = (size_t)4 * lda, sb = (size_t)4 * ldb;
        g_load<NB>(ra0, rb0, Ag, Bg, sa, sb, 1);
        __syncthreads();
        f32x4 acc[MI][4];
#pragma unroll
        for (int i = 0; i < MI; ++i)
#pragma unroll
            for (int j = 0; j < 4; ++j) acc[i][j] = (f32x4){0.f, 0.f, 0.f, 0.f};
        const int nk = K >> 6;
        for (int kt = 0; kt < nk; kt += 2) {
            __builtin_amdgcn_s_setprio(1);
            g_load<NB>(ra1, rb1, Ag, Bg, sa, sb, kt + 2 < nk ? kt + 2 : nk - 1);
            g_compute<MI, TRANS>(acc, lds + aoff, lds + boff, fq, sw);
            g_write<NB>(ra0, rb0, lds + 32768 + woff);
            sched_pattern();
            __builtin_amdgcn_s_setprio(0);
            __syncthreads();
            __builtin_amdgcn_s_setprio(1);
            g_load<NB>(ra0, rb0, Ag, Bg, sa, sb, kt + 3 < nk ? kt + 3 : nk - 1);
            g_compute<MI, TRANS>(acc, lds + 32768 + aoff, lds + 32768 + boff, fq, sw);
            g_write<NB>(ra1, rb1, lds + woff);
            sched_pattern();
            __builtin_amdgcn_s_setprio(0);
            __syncthreads();
        }
        if (ssq) {
            if (tid < 128) {
                float sacc = 0.f;
#pragma unroll
                for (int i = 0; i < 16; ++i) sacc += pr[i];
                ((float*)(lds + 65536))[tid] = rsqrtf(sacc * (1.0f / 1024.0f) + 1e-6f);
            }
            __syncthreads();
        }
        prefetch(m0n, n0n);
        epi.template operator()<MI>(acc, m0, n0, rbase, wc, fr, fq, lds);
    }
};

DEV void load_rstd(const float* ssq_site, int m0, unsigned char* lds) {
    __syncthreads();
    float* R = (float*)(lds + 65536);
    if (TIDX < 128) {
        float s = 0.f;
#pragma unroll
        for (int i = 0; i < 16; ++i) s += ssq_site[(size_t)i * MROWS + m0 + TIDX];
        R[TIDX] = rsqrtf(s * (1.0f / 1024.0f) + 1e-6f);
    }
    __syncthreads();
}

struct EpiIn {
    float* P; const float* SW; bf16_t* PF; float* out; int even; int jl;
    template <int MI> DEV void operator()(const f32x4 (&acc)[MI][4], int m0, int n0, int rbase, int wc, int fr, int fq, unsigned char* lds) const {
        const float* R = (const float*)(lds + 65536);
#pragma unroll
        for (int mi = 0; mi < MI; ++mi) {
            const int rl = rbase + mi * 16 + fr, row = m0 + rl;
            const float rs = R[rl];
            const float* sw = SW + vec_of_row(row) * 2048;
#pragma unroll
            for (int ni = 0; ni < 4; ++ni) {
                const int col = n0 + wc * 64 + ni * 16 + fq * 4;
                const f32x4 s4 = *(const f32x4*)(sw + col);
                f32x4 v = acc[mi][ni] * rs + s4;
                *(f32x4*)(P + (size_t)row * 2048 + col) = v;
                if (even) {
                    if (row < MCTX && col >= 512 && col < 768) {
                        const int b = row >> 8, lp = row & 255;
                        const size_t o = ((size_t)(b * 2 + jl) * 256 + lp) * 128;
                        if (col < 640) *(f32x4*)(out + OUT_K + o + (col - 512)) = v;
                        else *(f32x4*)(out + OUT_V + o + (col - 640)) = v;
                    }
                } else if (col < 512) {
                    uint2 w; w.x = pack2(v[0], v[1]); w.y = pack2(v[2], v[3]);
                    *(uint2*)(PF + (size_t)row * 512 + col) = w;
                }
            }
        }
    }
};
struct EpiInF {
    const float* SW; bf16_t* PF;
    template <int MI> DEV void operator()(const f32x4 (&acc)[MI][4], int m0, int n0, int rbase, int wc, int fr, int fq, unsigned char* lds) const {
        const float* R = (const float*)(lds + 65536);
#pragma unroll
        for (int mi = 0; mi < MI; ++mi) {
            const int rl = rbase + mi * 16 + fr, row = m0 + rl;
            const float rs = R[rl];
            const float* sw = SW + vec_of_row(row) * 2048;
#pragma unroll
            for (int ni = 0; ni < 4; ++ni) {
                const int col = n0 + wc * 64 + ni * 16 + fq * 4;
                const f32x4 v = acc[mi][ni] * rs + *(const f32x4*)(sw + col);
                uint2 w; w.x = pack2(v[0], v[1]); w.y = pack2(v[2], v[3]);
                *(uint2*)(PF + (size_t)row * 512 + col) = w;
            }
        }
    }
};
struct EpiInT {
    const float* SW; bf16_t* PT; int coff;
    template <int MI> DEV void operator()(const f32x4 (&acc)[MI][4], int m0, int n0, int rbase, int wc, int fr, int fq, unsigned char* lds) const {
        const float* R = (const float*)(lds + 65536);
#pragma unroll
        for (int mi = 0; mi < MI; ++mi) {
            const int rl = rbase + mi * 16 + fq * 4, row = m0 + rl;
            const f32x4 rs = *(const f32x4*)(R + rl);
            const float* sw = SW + vec_of_row(row) * 2048;
#pragma unroll
            for (int ni = 0; ni < 4; ++ni) {
                const int col = n0 + wc * 64 + ni * 16 + fr;
                const float sv = sw[col];
                const f32x4 v = acc[mi][ni] * rs + sv;
                uint2 w; w.x = pack2(v[0], v[1]); w.y = pack2(v[2], v[3]);
                *(uint2*)(PT + (size_t)(col + coff - 512) * MROWS + row) = w;
            }
        }
    }
};
struct EpiRes {
    float* X; bf16_t* XG; const float* gate;   const float* nw; const float* nscale;   float* ssq; int write_xg; float gscale;
    template <int MI> DEV void operator()(const f32x4 (&acc)[MI][4], int m0, int n0, int rbase, int wc, int fr, int fq, unsigned char*) const {
#pragma unroll
        for (int mi = 0; mi < MI; ++mi) {
            const int row = m0 + rbase + mi * 16 + fr;
            const int v = vec_of_row(row);
            float ss = 0.f;
#pragma unroll
            for (int ni = 0; ni < 4; ++ni) {
                const int col = n0 + wc * 64 + ni * 16 + fq * 4;
                const f32x4 g4 = *(const f32x4*)(gate + v * 6144 + col);
                f32x4 x = *(const f32x4*)(X + (size_t)row * 1024 + col);
                x = x + g4 * acc[mi][ni] * gscale;
                *(f32x4*)(X + (size_t)row * 1024 + col) = x;
                ss += x[0] * x[0] + x[1] * x[1] + x[2] * x[2] + x[3] * x[3];
                if (write_xg) {
                    const f32x4 w4 = *(const f32x4*)(nw + col);
                    const f32x4 s4 = *(const f32x4*)(nscale + v * 6144 + col);
                    const f32x4 y = x * w4 * (s4 + 1.0f);
                    uint2 w; w.x = pack2(y[0], y[1]); w.y = pack2(y[2], y[3]);
                    *(uint2*)(XG + (size_t)row * 1024 + col) = w;
                }
            }
            ss += __shfl_xor(ss, 16); ss += __shfl_xor(ss, 32);
            if (fq == 0) ssq[(size_t)((n0 + wc * 64) >> 6) * MROWS + row] = ss;
        }
    }
};
struct EpiMlp1 {
    bf16_t* H; const float* SW;
    template <int MI> DEV void operator()(const f32x4 (&acc)[MI][4], int m0, int n0, int rbase, int wc, int fr, int fq, unsigned char* lds) const {
        const float* R = (const float*)(lds + 65536);
#pragma unroll
        for (int mi = 0; mi < MI; ++mi) {
            const int rl = rbase + mi * 16 + fr, row = m0 + rl;
            const float rs = R[rl];
            const float* sw = SW + vec_of_row(row) * 4096;
#pragma unroll
            for (int ni = 0; ni < 4; ++ni) {
                const int col = n0 + wc * 64 + ni * 16 + fq * 4;
                const f32x4 s4 = *(const f32x4*)(sw + col);
                f32x4 v = acc[mi][ni] * rs + s4;
#pragma unroll
                for (int e = 0; e < 4; ++e) { float r = fmaxf(v[e], 0.f); v[e] = r * r; }
                uint2 w; w.x = pack2(v[0], v[1]); w.y = pack2(v[2], v[3]);
                *(uint2*)(H + (size_t)row * 4096 + col) = w;
            }
        }
    }
};
struct EpiF1 {
    bf16_t* FT; int L; int g;
    template <int MI> DEV void operator()(const f32x4 (&acc)[MI][4], int m0, int n0, int rbase, int wc, int fr, int fq, unsigned char*) const {
#pragma unroll
        for (int mi = 0; mi < MI; ++mi) {
            const int n = m0 + rbase + mi * 16 + fr;
            bf16_t* dst = FT + (size_t)(g * 128 + (n & 127)) * (2 * L) + (n >> 7) * L;
#pragma unroll
            for (int ni = 0; ni < 4; ++ni) {
                const int col = n0 + wc * 64 + ni * 16 + fq * 4;
                uint2 w; w.x = pack2(acc[mi][ni][0], acc[mi][ni][1]); w.y = pack2(acc[mi][ni][2], acc[mi][ni][3]);
                *(uint2*)(dst + col) = w;
            }
        }
    }
};
struct EpiF2 {
    bf16_t* MIX; int rowbase;
    template <int MI> DEV void operator()(const f32x4 (&acc)[MI][4], int m0, int n0, int rbase, int wc, int fr, int fq, unsigned char*) const {
#pragma unroll
        for (int mi = 0; mi < MI; ++mi) {
            const int row = rowbase + m0 + rbase + mi * 16 + fr;
#pragma unroll
            for (int ni = 0; ni < 4; ++ni) {
                const int col = n0 + wc * 64 + ni * 16 + fq * 4;
                uint2 w; w.x = pack2(acc[mi][ni][0], acc[mi][ni][1]); w.y = pack2(acc[mi][ni][2], acc[mi][ni][3]);
                *(uint2*)(MIX + (size_t)row * 1024 + col) = w;
            }
        }
    }
};

DEV void tile_decode(int t, int NT, int& pm, int& pn) { const int g = t / (4 * NT), r = t % (4 * NT); pn = r >> 2; pm = g * 4 + (r & 3); }

struct TrDesc { const float* src; bf16_t* dst; int K, N; };
DEV TrDesc tr_decode(const Params& p, int t) {
    unsigned char* ws = p.ws;
    int l = 0;
    for (;;) { const int cnt = (l & 1) ? 2816 : 2752; if (t < cnt) break; t -= cnt; ++l; }
    const int j = l >> 1, odd = l & 1;
    const int nin = odd ? 2048 : 1792, tin = 16 * (nin / 64);
    const float* W; bf16_t* Wt; int K, N, kt, nt;
    if (t < tin) { W = odd ? p.in[24] + (size_t)j * 1024 * 2048 : p.in[14] + (size_t)j * 1024 * 1792; Wt = (bf16_t*)(ws + OFF_WTIN) + (size_t)l * 2048 * 1024; K = 1024; N = nin; kt = t % 16; nt = t / 16; }
    else if (t < tin + 256) { t -= tin; W = (odd ? p.in[25] : p.in[15]) + (size_t)j * 1024 * 1024; Wt = (bf16_t*)(ws + OFF_WTOUT) + (size_t)l * 1024 * 1024; K = 1024; N = 1024; kt = t % 16; nt = t / 16; }
    else if (t < tin + 256 + 1024) { t -= tin + 256; W = p.in[12] + (size_t)l * 1024 * 4096; Wt = (bf16_t*)(ws + OFF_WT1) + (size_t)l * 4096 * 1024; K = 1024; N = 4096; kt = t % 16; nt = t / 16; }
    else { t -= tin + 256 + 1024; W = p.in[13] + (size_t)l * 4096 * 1024; Wt = (bf16_t*)(ws + OFF_WT2) + (size_t)l * 1024 * 4096; K = 4096; N = 1024; kt = t % 64; nt = t / 64; }
    TrDesc d; d.src = W + (size_t)kt * 64 * N + nt * 64; d.dst = Wt + (size_t)nt * 64 * K + kt * 64; d.K = K; d.N = N;
    return d;
}
DEV void tr_load(const TrDesc& d, f32x4 (&r)[4], int tid) {
    const int r0 = tid >> 4, c4 = (tid & 15) * 4;
#pragma unroll
    for (int i = 0; i < 4; ++i) r[i] = __builtin_nontemporal_load((const f32x4*)(d.src + (size_t)(r0 + 16 * i) * d.N + c4));
}
DEV void tr_store(const TrDesc& d, const f32x4 (&r)[4], float* lds, int tid) {
    const int r0 = tid >> 4, c4 = (tid & 15) * 4;
    __syncthreads();
#pragma unroll
    for (int i = 0; i < 4; ++i)
#pragma unroll
        for (int e = 0; e < 4; ++e) lds[(r0 + 16 * i) * 65 + c4 + e] = r[i][e];
    __syncthreads();
    const int n = tid >> 2, kc = (tid & 3) * 16;
    unsigned w[8];
#pragma unroll
    for (int e = 0; e < 8; ++e) w[e] = pack2(lds[(kc + 2 * e) * 65 + n], lds[(kc + 2 * e + 1) * 65 + n]);
    uint4* dst = (uint4*)(d.dst + (size_t)n * d.K + kc);
    dst[0] = make_uint4(w[0], w[1], w[2], w[3]);
    dst[1] = make_uint4(w[4], w[5], w[6], w[7]);
}

DEV void gemv3_unit(const float* vecs  , const float* __restrict__ W, int N, int col0, const float* bias, float* out, int ostride, float* red  ) {
    const int w = TIDX >> 6, lane = TIDX & 63;
    const float* Wp = W + col0 + lane;
    float a0 = 0.f, a1 = 0.f, a2 = 0.f;
#pragma unroll 32
    for (int k = w * 256; k < w * 256 + 256; ++k) {
        const float wv = __builtin_nontemporal_load(Wp + (size_t)k * N);
        a0 += vecs[k] * wv; a1 += vecs[1024 + k] * wv; a2 += vecs[2048 + k] * wv;
    }
    red[(w * 3 + 0) * 64 + lane] = a0; red[(w * 3 + 1) * 64 + lane] = a1; red[(w * 3 + 2) * 64 + lane] = a2;
    __syncthreads();
    if (TIDX < 192) {
        const int v = TIDX >> 6;
        float s = red[(0 * 3 + v) * 64 + lane] + red[(1 * 3 + v) * 64 + lane] + red[(2 * 3 + v) * 64 + lane] + red[(3 * 3 + v) * 64 + lane];
        if (bias) s += bias[col0 + lane];
        out[(size_t)v * ostride + col0 + lane] = s;
    }
    __syncthreads();
}

DEV void phase_prepA(const Params& p, unsigned char* lds, int vb, int G) {
    unsigned char* ws = p.ws;
    float* fl = (float*)lds;
    const int NU = 977;
    for (int u = vb; u < NU; u += G) {
        if (u < 384) {
            const int l = u / 96, ct = u % 96;
            __syncthreads();
            for (int i = TIDX; i < 3072; i += 256) {
                const int v = i >> 10, k = i & 1023;
                const float cv = (v == 0) ? p.in[6][k] : p.in[2][(v - 1) * 1024 + k];
                fl[i] = cv / (1.0f + expf(-cv));
            }
            __syncthreads();
            gemv3_unit(fl, p.in[7] + (size_t)l * 1024 * 6144, 6144, ct * 64, p.in[8] + l * 6144, (float*)(ws + OFF_MOD) + l * 3 * 6144, 6144, fl + 3072);
        } else if (u < 424) {
            const int uu = u - 384, j = uu / 20, tb = uu % 20;
            const float* w1 = p.in[28] + j * 33 * 64; const float* b1 = p.in[29] + j * 64;
            const float* w2 = p.in[30] + j * 64 * 64; const float* b2 = p.in[31] + j * 64;
            const float* fr_ = p.in[33] + j * 128;
            float* HID = (float*)(ws + OFF_HID) + (size_t)j * 1280 * 64;
            float* zb = fl; float* h1 = fl + 256;
            const int o = TIDX & 63, tg = TIDX >> 6;
            float w1c[33], w2c[64];
#pragma unroll
            for (int e = 0; e < 33; ++e) w1c[e] = w1[e * 64 + o];
#pragma unroll
            for (int e = 0; e < 64; ++e) w2c[e] = w2[e * 64 + o];
            const float b1o = b1[o], b2o = b2[o], f0o = fr_[o], f1o = fr_[64 + o];
#pragma unroll 1
            for (int it = 0; it < 16; ++it) {
                const int gp = tb * 64 + it * 4 + tg;
                const int L = gp < 256 ? 256 : 1024, t = gp < 256 ? gp : gp - 256;
                __syncthreads();
                if (o < 33) {
                    float z;
                    if (o == 0) z = (float)t / (float)L;
                    else {
                        const int bi = (o - 1) & 15;
                        const float band = 1e-4f + (float)bi * ((15.0f - 1e-4f) / 15.0f);
                        const float w = (6.283185307179586f / (float)L) * (float)t;
                        const float a = w * band;
                        z = (o <= 16) ? cosf(a) : -sinf(a);
                    }
                    zb[tg * 40 + o] = z;
                }
                __syncthreads();
                float s = b1o;
#pragma unroll
                for (int e = 0; e < 33; ++e) s += zb[tg * 40 + e] * w1c[e];
                h1[tg * 64 + o] = sinf(f0o * s);
                __syncthreads();
                float s2 = b2o;
#pragma unroll
                for (int e = 0; e < 64; ++e) s2 += h1[tg * 64 + e] * w2c[e];
                HID[(size_t)gp * 64 + o] = sinf(f1o * s2);
            }
        } else if (u < 977) {
            const int e0 = (u - 424) * 4096;
            for (int i = TIDX; i < 4096; i += 256) {
                const int e = e0 + i;
                if (e < 32768) {
                    const int n = e >> 7, k = e & 127;
                    const float a = 6.283185307179586f * (float)(((n & 127) * k) & 127) / 128.0f;
                    ((bf16_t*)(ws + OFF_CS128))[e] = f2bf(n < 128 ? cosf(a) : sinf(a));
                } else if (e < 163840) {
                    const int q = e - 32768, lp = q >> 9, k2 = q & 511, l = k2 & 255;
                    const float a = 6.283185307179586f * (float)((lp * l) & 255) / 256.0f;
                    const float sc = 0.005524271728019903f;
                    ((bf16_t*)(ws + OFF_CSL256))[q] = f2bf(k2 < 256 ? sc * cosf(a) : -sc * sinf(a));
                } else if (e < 2260992) {
                    const int q = e - 163840, lp = q >> 11, k2 = q & 2047, l = k2 & 1023;
                    const float a = 6.283185307179586f * (float)((lp * l) & 1023) / 1024.0f;
                    const float sc = 0.0027621358640099515f;
                    ((bf16_t*)(ws + OFF_CSL1024))[q] = f2bf(k2 < 1024 ? sc * cosf(a) : -sc * sinf(a));
                } else if (e < 2262016) {
                    const int q = e - 2260992, pos = q >> 4, i2 = q & 15;
                    const float inv = powf(10000.0f, -(float)i2 / 16.0f);
                    const float a = (float)pos * inv;
                    ((float2*)(ws + OFF_ROPE))[q] = make_float2(cosf(a), sinf(a));
                }
            }
        }
    }
    {
        const int tid = TIDX;
        const int NTT = 11136;
        int t = vb;
        if (t < NTT) {
            TrDesc d = tr_decode(p, t);
            f32x4 r[4];
            tr_load(d, r, tid);
            while (t < NTT) {
                const int tn = t + G;
                const TrDesc dn = tr_decode(p, tn < NTT ? tn : t);
                f32x4 rn[4];
                tr_load(dn, rn, tid);
                tr_store(d, r, fl, tid);
                d = dn;
#pragma unroll
                for (int i = 0; i < 4; ++i) r[i] = rn[i];
                t = tn;
            }
        }
    }
}

DEV void sw_unit(const Params& p, int u, unsigned char* lds) {
    unsigned char* ws = p.ws;
    const float* MOD = (const float*)(ws + OFF_MOD);
    int t = u, l = 0;
    for (;;) { const int cnt = (l & 1) ? 96 : 92; if (t < cnt) break; t -= cnt; ++l; }
    const int odd = l & 1, nin = odd ? 2048 : 1792, tin = nin / 64;
    const int which = t < tin ? 0 : 1;
    const int tid = TIDX, lane = tid & 63, w = tid >> 6;
    const bf16_t* WT = which == 0 ? (const bf16_t*)(ws + OFF_WTIN) + (size_t)l * 2048 * 1024 : (const bf16_t*)(ws + OFF_WT1) + (size_t)l * 4096 * 1024;
    float* out = which == 0 ? (float*)(ws + OFF_SWIN) + l * 3 * 2048 : (float*)(ws + OFF_SW1) + l * 3 * 4096;
    const int ostride = which == 0 ? 2048 : 4096;
    const int col0 = (which == 0 ? t : t - tin) * 64 + w * 16;
    f32x4 sv[3][4];
#pragma unroll
    for (int v = 0; v < 3; ++v)
#pragma unroll
        for (int q = 0; q < 4; ++q) sv[v][q] = *(const f32x4*)(MOD + (l * 3 + v) * 6144 + (which ? 3 : 0) * 1024 + lane * 16 + q * 4);
#pragma unroll 4
    for (int i = 0; i < 16; ++i) {
        const u32x4* rp = (const u32x4*)(WT + (size_t)(col0 + i) * 1024 + lane * 16);
        const u32x4 r0 = rp[0], r1 = rp[1];
        const unsigned wv[8] = {r0.x, r0.y, r0.z, r0.w, r1.x, r1.y, r1.z, r1.w};
        float a[3] = {0.f, 0.f, 0.f};
#pragma unroll
        for (int e = 0; e < 8; ++e) {
            const float lo = __uint_as_float(wv[e] << 16), hi = __uint_as_float(wv[e] & 0xffff0000u);
#pragma unroll
            for (int v = 0; v < 3; ++v) a[v] += sv[v][e >> 1][(e & 1) * 2] * lo + sv[v][e >> 1][(e & 1) * 2 + 1] * hi;
        }
#pragma unroll
        for (int v = 0; v < 3; ++v) {
#pragma unroll
            for (int o = 32; o >= 1; o >>= 1) a[v] += __shfl_xor(a[v], o);
        }
        if (lane == 0) { out[col0 + i] = a[0]; out[ostride + col0 + i] = a[1]; out[2 * ostride + col0 + i] = a[2]; }
    }
}
DEV void filter_unit(const Params& p, int uu0, unsigned char* lds) {
    unsigned char* ws = p.ws;
    float* fl = (float*)lds;
    const int tid0 = TIDX;
    const int u = uu0 + 376;
    {
            const int uu = u - 376;
            const int cgp = uu & 31, n = (uu >> 5) & 1, ls = (uu >> 6) & 1, j = uu >> 7;
            const int L = ls ? 1024 : 256;
            const int colid = tid0 & 31, tq = tid0 >> 5;
            const int dir = colid >> 4, c = cgp * 16 + (colid & 15);
            const int col = dir * 1024 + n * 512 + c;
            const float* w3 = p.in[32] + (size_t)j * 64 * 2048 + col;
            const float dec = expf(p.in[34][j * 2048 + col]);
            const float* HID = (const float*)(ws + OFF_HID) + ((size_t)j * 1280 + (ls ? 256 : 0)) * 64;
            float* TF = (float*)(ws + OFF_TF + (size_t)j * 10 * MiB + (ls ? 2 * MiB : 0)) + ((size_t)n * 512 + c) * (2 * L);
            float wv[64];
#pragma unroll
            for (int e = 0; e < 64; ++e) wv[e] = w3[(size_t)e * 2048];
            float ss = 0.f;
            const int tper = L >> 3;
#pragma unroll 1
            for (int c0 = 0; c0 < tper; c0 += 16) {
                __syncthreads();
#pragma unroll
                for (int k = 0; k < 8; ++k) {
                    const int e = tid0 + 256 * k, r = e >> 4, c4 = e & 15;
                    *(f32x4*)(fl + r * 64 + c4 * 4) = *(const f32x4*)(HID + (size_t)((r >> 4) * tper + c0 + (r & 15)) * 64 + c4 * 4);
                }
                __syncthreads();
#pragma unroll 1
                for (int i = 0; i < 16; ++i) {
                    const int t = tq * tper + c0 + i;
                    const float* h = fl + (tq * 16 + i) * 64;
                    float sacc = 0.f;
#pragma unroll
                    for (int e = 0; e < 64; e += 4) { const f32x4 hv = *(const f32x4*)(h + e); sacc += hv[0] * wv[e] + hv[1] * wv[e + 1] + hv[2] * wv[e + 2] + hv[3] * wv[e + 3]; }
                    sacc *= expf(-((float)t / (float)L) * dec);
                    ss += sacc * sacc;
                    TF[dir ? (L + t) : (L - 1 - t)] = sacc;
                }
            }
            __syncthreads();
            fl[tq * 32 + colid] = ss;
            __syncthreads();
            const int cl = colid & 15;
            float tot = 0.f;
#pragma unroll
            for (int q = 0; q < 8; ++q) tot += fl[q * 32 + cl] + fl[q * 32 + 16 + cl];
            if (tid0 < 16) ((float*)(ws + OFF_HID + 655360))[((j * 2 + ls) * 2 + n) * 512 + cgp * 16 + tid0] = rsqrtf(tot + 1e-6f);
            __syncthreads();
    }
}
DEV void phase_prepB(const Params& p, unsigned char* lds, int vb, int G) {
    unsigned char* ws = p.ws;
    const float* MOD = (const float*)(ws + OFF_MOD);
    for (int u0 = vb; u0 < 668; u0 += G) {
        if (u0 < 28) sw_unit(p, u0, lds);
        else {
            const int u = u0 - 28 + 632;
            const int r0 = (u - 632) * 16 + (TIDX >> 6) * 4, lane = TIDX & 63;
            float* X = (float*)(ws + OFF_X); bf16_t* XG = (bf16_t*)(ws + OFF_XG); float* SSQ = (float*)(ws + OFF_SSQ);
            for (int rr = 0; rr < 4; ++rr) {
                const int row = r0 + rr, v = vec_of_row(row);
                const float* src = row < MCTX ? p.in[0] + (size_t)row * 1024 : p.in[1] + (size_t)(row - MCTX) * 1024;
                float ss = 0.f;
#pragma unroll
                for (int i = 0; i < 4; ++i) {
                    const int col = lane * 4 + i * 256;
                    const f32x4 x = *(const f32x4*)(src + col);
                    ss += x[0] * x[0] + x[1] * x[1] + x[2] * x[2] + x[3] * x[3];
                    *(f32x4*)(X + (size_t)row * 1024 + col) = x;
                    const f32x4 w4 = *(const f32x4*)(p.in[9] + col);
                    const f32x4 s4 = *(const f32x4*)(MOD + v * 6144 + 1024 + col);
                    const f32x4 y = x * w4 * (s4 + 1.0f);
                    uint2 w; w.x = pack2(y[0], y[1]); w.y = pack2(y[2], y[3]);
                    *(uint2*)(XG + (size_t)row * 1024 + col) = w;
                }
#pragma unroll
                for (int o = 32; o >= 1; o >>= 1) ss += __shfl_xor(ss, o);
                if (lane < 16) SSQ[(size_t)lane * MROWS + row] = lane == 0 ? ss : 0.f;
            }
        }
    }
}

template <bool TRANS, class Epi>
DEV void gemm_in_loop(const bf16_t* A, const bf16_t* Bt, const float* ssq, unsigned char* lds, int vb, int rev, int ntile, int NT, int G, const Epi& epi) {
    const int nfull = ntile / G, R = ntile - nfull * G, slots = G >> 3;
    const int q = rev ? slots - 1 - (int)(blockIdx.x >> 3) : (int)(blockIdx.x >> 3);
    const int extra = ((G & 7) == 0 && (R & 7) == 0) ? (q < (R >> 3) ? nfull * G + (int)(blockIdx.x & 7) * (R >> 3) + q : -1) : (vb < R ? nfull * G + vb : -1);
    const int cnt = nfull + (extra >= 0 ? 1 : 0);
    if (cnt == 0) return;
    GStream<128> gs; gs.init(A, 1024, Bt, 1024, 1024, ssq, lds);
    int i = 0;
    int t = nfull > 0 ? vb : extra;
    int pm, pn; tile_decode(t, NT, pm, pn);
    gs.prefetch(pm * 128, pn * 128);
    for (;;) {
        const int inx = i + 1;
        const int tn = inx < nfull ? vb + inx * G : (inx < cnt ? extra : t);
        int pmn, pnn; tile_decode(tn, NT, pmn, pnn);
        gs.template run_tile<TRANS>(pm * 128, pn * 128, pmn * 128, pnn * 128, epi);
        if (inx >= cnt) break;
        i = inx; t = tn; pm = pmn; pn = pnn;
    }
}
DEV void phase_gemm_in(const Params& p, int l, unsigned char* lds, int vb, int G) {
    unsigned char* ws = p.ws;
    const int odd = l & 1;
    const float* ssq = (const float*)(ws + OFF_SSQ) + (size_t)(2 * l) * 16 * MROWS;
    const bf16_t* A = (const bf16_t*)(ws + OFF_XG); const bf16_t* Bt = (const bf16_t*)(ws + OFF_WTIN) + (size_t)l * 2048 * 1024;
    const float* SW = (const float*)(ws + OFF_SWIN) + l * 3 * 2048;
    if (!odd) {
        EpiIn epi; epi.P = (float*)(ws + OFF_P); epi.SW = SW; epi.PF = (bf16_t*)(ws + OFF_PF); epi.out = p.out; epi.even = 1; epi.jl = l >> 1;
        if (G == 512) {
            gemm_in_loop<false>(A, Bt, ssq, lds, vb, 0, 1024, 14, G, epi);
            const int q = (int)(blockIdx.x >> 3);
            if (q < 24) {
                const int h = (int)(blockIdx.x & 7) * 24 + q;
                int pm, pn; tile_decode(1024 + (h >> 1), 14, pm, pn);
                GStream<64> g2; g2.init(A, 1024, Bt, 1024, 1024, ssq, lds);
                g2.prefetch(pm * 128, pn * 128 + (h & 1) * 64);
                g2.run_tile<false>(pm * 128, pn * 128 + (h & 1) * 64, pm * 128, pn * 128 + (h & 1) * 64, epi);
            }
        } else gemm_in_loop<false>(A, Bt, ssq, lds, vb, 0, 80 * 14, 14, G, epi);
    } else {
        EpiInF ef; ef.SW = SW; ef.PF = (bf16_t*)(ws + OFF_PF);
        EpiInT et; et.SW = SW; et.PT = (bf16_t*)(ws + OFF_HU); et.coff = 0;
        gemm_in_loop<false>(A, Bt, ssq, lds, vb, 0, 320, 4, G, ef);
        EpiInT et2 = et; et2.SW = SW + 512; et2.PT = et.PT;
        et2.coff = 512;
        gemm_in_loop<true>(A, Bt + (size_t)512 * 1024, ssq, lds, vb, 1, 960, 12, G, et2);
    }
}
DEV void phase_gemm_res(const Params& p, int l, int which  , unsigned char* lds, int vb, int G, float gscale = 1.0f) {
    unsigned char* ws = p.ws;
    const float* MOD = (const float*)(ws + OFF_MOD);
    EpiRes epi; epi.X = (float*)(ws + OFF_X); epi.XG = (bf16_t*)(ws + OFF_XG); epi.gscale = gscale;
    const bf16_t* A; const bf16_t* Bt; int K;
    if (which == 0) {
        epi.gate = MOD + (size_t)l * 3 * 6144 + 2 * 1024; epi.nw = p.in[10] + l * 1024; epi.nscale = MOD + (size_t)l * 3 * 6144 + 4 * 1024;
        epi.ssq = (float*)(ws + OFF_SSQ) + (size_t)(2 * l + 1) * 16 * MROWS; epi.write_xg = 1;
        A = (const bf16_t*)(ws + OFF_MIX); Bt = (const bf16_t*)(ws + OFF_WTOUT) + (size_t)l * 1024 * 1024; K = 1024;
    } else {
        const int ln = l < 3 ? l + 1 : 3;
        epi.gate = MOD + (size_t)l * 3 * 6144 + 5 * 1024; epi.nw = p.in[9] + ln * 1024; epi.nscale = MOD + (size_t)ln * 3 * 6144 + 1 * 1024;
        epi.ssq = (float*)(ws + OFF_SSQ) + (size_t)(2 * l + 2) * 16 * MROWS; epi.write_xg = l < 3;
        A = (const bf16_t*)(ws + OFF_P); Bt = (const bf16_t*)(ws + OFF_WT2) + (size_t)l * 1024 * 4096; K = 4096;
    }
    int t = vb;
    if (t >= 640) return;
    int pm, pn; tile_decode(t, 8, pm, pn);
    {
        GStream<128> gs; gs.init(A, K, Bt, K, K, nullptr, lds);
        gs.prefetch(pm * 128, pn * 128);
        gs.run_tile<false>(pm * 128, pn * 128, pm * 128, pn * 128, epi);
        if (G != 512) { for (int t3 = vb + G; t3 < 640; t3 += G) { tile_decode(t3, 8, pm, pn); gs.prefetch(pm * 128, pn * 128); gs.run_tile<false>(pm * 128, pn * 128, pm * 128, pn * 128, epi); } return; }
    }
    if ((int)(blockIdx.x >> 3) < 32) {
        const int h = (int)(blockIdx.x & 7) * 32 + (int)(blockIdx.x >> 3);
        tile_decode(512 + (h >> 1), 8, pm, pn);
        GStream<64> g2; g2.init(A, K, Bt, K, K, nullptr, lds);
        g2.prefetch(pm * 128, pn * 128 + (h & 1) * 64);
        g2.run_tile<false>(pm * 128, pn * 128 + (h & 1) * 64, pm * 128, pn * 128 + (h & 1) * 64, epi);
    }
}
DEV void phase_gemm_mlp1(const Params& p, int l, unsigned char* lds, int vb, int G) {
    unsigned char* ws = p.ws;
    EpiMlp1 epi; epi.H = (bf16_t*)(ws + OFF_P); epi.SW = (const float*)(ws + OFF_SW1) + l * 3 * 4096;
    const float* ssq = (const float*)(ws + OFF_SSQ) + (size_t)(2 * l + 1) * 16 * MROWS;
    const bf16_t* A = (const bf16_t*)(ws + OFF_XG); const bf16_t* Bt = (const bf16_t*)(ws + OFF_WT1) + (size_t)l * 4096 * 1024;
    int t = vb;
    if (t >= 2560) return;
    GStream<128> gs; gs.init(A, 1024, Bt, 1024, 1024, ssq, lds);
    int pm, pn; tile_decode(t, 32, pm, pn);
    gs.prefetch(pm * 128, pn * 128);
    for (;;) {
        const int tn = t + G, tq = tn < 2560 ? tn : t;
        int pmn, pnn; tile_decode(tq, 32, pmn, pnn);
        gs.run_tile<false>(pm * 128, pn * 128, pmn * 128, pnn * 128, epi);
        if (tn >= 2560) break;
        t = tn; pm = pmn; pn = pnn;
    }
}

DEV float gelu_tanh(float x) { const float u = 0.7978845608028654f * (x + 0.044715f * x * x * x); return 0.5f * x * (1.0f + tanhf(u)); }

DEV void attn_unit(const Params& p, int jl, int latent, int b, int kv, int qt, unsigned char* lds) {
    unsigned char* ws = p.ws;
    const float* P = (const float*)(ws + OFF_P);
    const float2* ROPE = (const float2*)(ws + OFF_ROPE);
    bf16_t* MIX = (bf16_t*)(ws + OFF_MIX);
    const int tid = TIDX, lane = tid & 63, g = tid >> 6, fr = lane & 15, fq = lane >> 4;
    const int h = kv * 4 + g;
    const int rowbase = latent ? MCTX + b * 1024 : b * 256;
    const int q0 = qt * 32;
    bf16x8 qf[2][2];
#pragma unroll
    for (int qs = 0; qs < 2; ++qs) {
        const int lq = q0 + qs * 16 + fr;
        const float* qp = P + (size_t)(rowbase + lq) * 2048 + h * 64;
#pragma unroll
        for (int dk = 0; dk < 2; ++dk) {
            const int d0 = dk * 32 + fq * 8;
            f32x4 x0 = *(const f32x4*)(qp + d0), x1 = *(const f32x4*)(qp + d0 + 4);
            float xv[8] = {x0[0], x0[1], x0[2], x0[3], x1[0], x1[1], x1[2], x1[3]};
            if (latent) {
                const int dp = d0 ^ 16;
                f32x4 y0 = *(const f32x4*)(qp + dp), y1 = *(const f32x4*)(qp + dp + 4);
                float yv[8] = {y0[0], y0[1], y0[2], y0[3], y1[0], y1[1], y1[2], y1[3]};
                const int pos = dk == 0 ? (lq >> 6) : (lq & 63);
                const float sgn = (fq & 2) ? 1.0f : -1.0f;
#pragma unroll
                for (int e = 0; e < 8; ++e) { const float2 cs = ROPE[pos * 16 + (fq & 1) * 8 + e]; xv[e] = xv[e] * cs.x + sgn * yv[e] * cs.y; }
            }
#pragma unroll
            for (int e = 0; e < 8; ++e) qf[qs][dk][e] = (short)f2bf(xv[e] * 0.125f);
        }
    }
    float m[2], lsum[2];
    f32x4 o[2][4];
#pragma unroll
    for (int qs = 0; qs < 2; ++qs) {
        m[qs] = p.in[16][jl * 8 + h]; lsum[qs] = fq == 0 ? 1.0f : 0.0f;
#pragma unroll
        for (int i = 0; i < 4; ++i) o[qs][i] = (f32x4){0.f, 0.f, 0.f, 0.f};
    }
    int lo = 0, nwin = 8;
    if (latent) { lo = q0 - 128; if (lo < 0) lo = 0; lo &= ~31; int hi = q0 + 32 + 128 + 31; hi &= ~31; if (hi > 1024) hi = 1024; nwin = (hi - lo) >> 5; }
    const int ntiles = latent ? nwin + 8 : 8;
    unsigned char* KL = lds; unsigned char* VL = lds + 4096;
    const int skey = tid >> 3, sub = tid & 7;
    const int a = sub >> 2, i4 = (sub & 3) * 4;
    f32x4 x1, x2, v0, v1;
    {
        const int key0 = lo + skey;
        const float* r = P + (size_t)(rowbase + key0) * 2048; const float* ksrc = r + 512 + kv * 64; const float* vsrc = r + 640 + kv * 64;
        x1 = *(const f32x4*)(ksrc + a * 32 + i4); x2 = *(const f32x4*)(ksrc + a * 32 + 16 + i4);
        v0 = *(const f32x4*)(vsrc + sub * 8); v1 = *(const f32x4*)(vsrc + sub * 8 + 4);
    }
    for (int kt = 0; kt < ntiles; ++kt) {
        const bool win = kt < nwin;
        const int k0 = win ? lo + kt * 32 : (kt - nwin) * 32;
        const int key = k0 + skey;
        __syncthreads();
        {
            f32x4 o1 = x1, o2 = x2;
            if (latent && win) {
                const int pos = a == 0 ? (key >> 6) : (key & 63);
#pragma unroll
                for (int e = 0; e < 4; ++e) { const float2 cs = ROPE[pos * 16 + i4 + e]; o1[e] = x1[e] * cs.x - x2[e] * cs.y; o2[e] = x2[e] * cs.x + x1[e] * cs.y; }
            }
            const int swz = (skey >> 1) & 7;
            const int d1 = a * 32 + i4, d2 = d1 + 16;
            uint2 w1; w1.x = pack2(o1[0], o1[1]); w1.y = pack2(o1[2], o1[3]);
            uint2 w2; w2.x = pack2(o2[0], o2[1]); w2.y = pack2(o2[2], o2[3]);
            *(uint2*)(KL + skey * 128 + (((d1 >> 3) ^ swz) << 4) + (d1 & 7) * 2) = w1;
            *(uint2*)(KL + skey * 128 + (((d2 >> 3) ^ swz) << 4) + (d2 & 7) * 2) = w2;
#pragma unroll
            for (int e = 0; e < 4; ++e) {
                *(bf16_t*)(VL + (sub * 8 + e) * 80 + skey * 2) = f2bf(v0[e]);
                *(bf16_t*)(VL + (sub * 8 + 4 + e) * 80 + skey * 2) = f2bf(v1[e]);
            }
        }
        __syncthreads();
        {
            const int ktn = kt + 1 < ntiles ? kt + 1 : kt;
            const bool winn = ktn < nwin; const int keyn = (winn ? lo + ktn * 32 : (ktn - nwin) * 32) + skey;
            const float* ksrc; const float* vsrc;
            if (winn) { const float* r = P + (size_t)(rowbase + keyn) * 2048; ksrc = r + 512 + kv * 64; vsrc = r + 640 + kv * 64; }
            else { const size_t o2 = ((size_t)(b * 2 + jl) * 256 + keyn) * 128 + kv * 64; ksrc = p.in[3] + o2; vsrc = p.in[4] + o2; }
            x1 = *(const f32x4*)(ksrc + a * 32 + i4); x2 = *(const f32x4*)(ksrc + a * 32 + 16 + i4);
            v0 = *(const f32x4*)(vsrc + sub * 8); v1 = *(const f32x4*)(vsrc + sub * 8 + 4);
        }
        bf16x8 kf[2][2];
#pragma unroll
        for (int t = 0; t < 2; ++t) {
            const int kr = t * 16 + fr, swz = (kr >> 1) & 7;
#pragma unroll
            for (int dk = 0; dk < 2; ++dk) kf[t][dk] = *(const bf16x8*)(KL + kr * 128 + (((dk * 4 + fq) ^ swz) << 4));
        }
        bf16x8 vf[4];
#pragma unroll
        for (int dt = 0; dt < 4; ++dt) {
            const unsigned char* vp = VL + (dt * 16 + fr) * 80 + fq * 8;
            const s16x4 va = *(const s16x4*)vp, vb2 = *(const s16x4*)(vp + 32);
            vf[dt][0] = va[0]; vf[dt][1] = va[1]; vf[dt][2] = va[2]; vf[dt][3] = va[3]; vf[dt][4] = vb2[0]; vf[dt][5] = vb2[1]; vf[dt][6] = vb2[2]; vf[dt][7] = vb2[3];
        }
#pragma unroll
        for (int qs = 0; qs < 2; ++qs) {
            const int lq = q0 + qs * 16 + fr;
            f32x4 s[2];
#pragma unroll
            for (int t = 0; t < 2; ++t) {
                s[t] = (f32x4){0.f, 0.f, 0.f, 0.f};
#pragma unroll
                for (int dk = 0; dk < 2; ++dk) s[t] = __builtin_amdgcn_mfma_f32_16x16x32_bf16(kf[t][dk], qf[qs][dk], s[t], 0, 0, 0);
            }
            if (latent && win) {
#pragma unroll
                for (int t = 0; t < 2; ++t)
#pragma unroll
                    for (int jj = 0; jj < 4; ++jj) { const int kk = k0 + t * 16 + fq * 4 + jj; int d = lq - kk; d = d < 0 ? -d : d; if (d > 128) s[t][jj] = -1e30f; }
            }
            float mx = fmaxf(fmaxf(fmaxf(s[0][0], s[0][1]), fmaxf(s[0][2], s[0][3])), fmaxf(fmaxf(s[1][0], s[1][1]), fmaxf(s[1][2], s[1][3])));
            mx = fmaxf(mx, __shfl_xor(mx, 16)); mx = fmaxf(mx, __shfl_xor(mx, 32));
            const float mn = fmaxf(m[qs], mx);
            const float alpha = __expf(m[qs] - mn);
            m[qs] = mn;
            float ps = 0.f;
            bf16x8 pf;
#pragma unroll
            for (int t = 0; t < 2; ++t)
#pragma unroll
                for (int jj = 0; jj < 4; ++jj) { const float pv = __expf(s[t][jj] - mn); ps += pv; pf[t * 4 + jj] = (short)f2bf(pv); }
            lsum[qs] = lsum[qs] * alpha + ps;
#pragma unroll
            for (int dt = 0; dt < 4; ++dt) {
                o[qs][dt] = o[qs][dt] * alpha;
                o[qs][dt] = __builtin_amdgcn_mfma_f32_16x16x32_bf16(vf[dt], pf, o[qs][dt], 0, 0, 0);
            }
        }
    }
#pragma unroll
    for (int qs = 0; qs < 2; ++qs) {
        float ls = lsum[qs];
        ls += __shfl_xor(ls, 16); ls += __shfl_xor(ls, 32);
        const float inv = 1.0f / ls;
        bf16_t* dst = MIX + (size_t)(rowbase + q0 + qs * 16 + fr) * 1024 + h * 64;
#pragma unroll
        for (int dt = 0; dt < 4; ++dt) {
            uint2 w; w.x = pack2(o[qs][dt][0] * inv, o[qs][dt][1] * inv); w.y = pack2(o[qs][dt][2] * inv, o[qs][dt][3] * inv);
            *(uint2*)(dst + dt * 16 + fq * 4) = w;
        }
    }
}

DEV float fast_tanh(float u) { const float e = __expf(2.0f * u); return 1.0f - 2.0f / (e + 1.0f); }
DEV float gelu_fast(float x) { const float u = 0.7978845608028654f * (x + 0.044715f * x * x * x); return 0.5f * x * (1.0f + fast_tanh(u)); }
DEV float bf2f(bf16_t v) { return __uint_as_float((unsigned)v << 16); }
template <int NCH>
DEV void lru_unit(const Params& p, int jl, int latent, int b, int hb, int coff, unsigned char* lds, int dsel  ) {
    unsigned char* ws = p.ws;
    const float* P = (const float*)(ws + OFF_P);
    float* HF = (float*)(ws + OFF_HU);
    bf16_t* MIX = (bf16_t*)(ws + OFF_MIX);
    constexpr int NT = NCH / 16, AS = NCH + 4;
    const int tid = TIDX, lane = tid & 63, wid = tid >> 6, fr = lane & 15, fq = lane >> 4;
    const int L = latent ? 1024 : 256, rowbase = latent ? MCTX + b * 1024 : b * 256;
    unsigned char* XCb = lds;
    unsigned char* WT0 = lds + 16384;
    float* Al = (float*)(lds + 32768);
    float* Ul = (float*)(lds + 32768 + 17408);
    float* CN0 = (float*)(lds + 32768 + 2 * 17408);
    const int ch0 = hb * 64;
    const float* cw = p.in[17] + jl * 4 * 512; const float* cb = p.in[18] + jl * 512;
    const int sw = (fr >> 1) & 7;
    float* HB = HF + (size_t)MROWS * 512;
    static_assert(NCH <= 32, "two per-direction gate-weight images of 2*NCH rows must fit the 16 KB WT region");
    __syncthreads();
    for (int dir = (dsel < 0 ? 0 : dsel); dir < (dsel < 0 ? 2 : dsel + 1); ++dir) {
        const float* wr_ = p.in[19] + ((size_t)((jl * 2 + dir) * 8 + hb)) * 4096;
        const float* wi_ = p.in[21] + ((size_t)((jl * 2 + dir) * 8 + hb)) * 4096;
        unsigned char* WTd = WT0 + dir * 8192; float* CNd = CN0 + dir * 3 * NCH;
        for (int i = tid; i < 64 * 2 * NCH; i += 256) {
            const int ii = i / (2 * NCH), o = i % (2 * NCH);
            const float wv = o < NCH ? wr_[ii * 64 + coff + o] : wi_[ii * 64 + coff + o - NCH];
            *(bf16_t*)(WTd + o * 128 + ((((ii >> 3) ^ ((o >> 1) & 7))) << 4) + (ii & 7) * 2) = f2bf(wv);
        }
        if (tid < NCH) {
            const int c = (jl * 2 + dir) * 512 + ch0 + coff + tid;
            CNd[tid] = p.in[20][c]; CNd[NCH + tid] = p.in[22][c];
            const float lam = p.in[23][c];
            CNd[2 * NCH + tid] = fmaxf(-lam, 0.f) + log1pf(expf(-fabsf(lam)));
        }
    }
    for (int dir = (dsel < 0 ? 0 : dsel); dir < (dsel < 0 ? 2 : dsel + 1); ++dir) {
        const unsigned char* WT = WT0 + dir * 8192; const float* CN = CN0 + dir * 3 * NCH;
        float hstate = 0.f;
        if (latent && tid < NCH) hstate = p.in[5][((size_t)(b * 2 + jl) * 2 + dir) * 512 + ch0 + coff + tid];
        const int nsc = L / 128;
        const int c4 = (tid & 15) * 4, tk0 = (tid >> 4) * 8;
        f32x4 rows[11];
        {
            const int t0f = (dir == 0 ? 0 : nsc - 1) * 128;
#pragma unroll
            for (int r = 0; r < 11; ++r) {
                const int tt = t0f + tk0 + r - 2, ttc = tt < 0 ? 0 : (tt >= L ? L - 1 : tt);
                const f32x4 v = *(const f32x4*)(P + (size_t)(rowbase + ttc) * 2048 + 768 + ch0 + c4);
                rows[r] = (tt >= 0 && tt < L) ? v : (f32x4){0.f, 0.f, 0.f, 0.f};
            }
        }
        for (int sci = 0; sci < nsc; ++sci) {
            const int t0 = (dir == 0 ? sci : nsc - 1 - sci) * 128;
            __syncthreads();
            {
                const f32x4 cbv = *(const f32x4*)(cb + ch0 + c4);
                f32x4 cwv[4];
#pragma unroll
                for (int k = 0; k < 4; ++k) cwv[k] = *(const f32x4*)(cw + k * 512 + ch0 + c4);
#pragma unroll
                for (int i = 0; i < 8; ++i) {
                    f32x4 sacc = cbv;
#pragma unroll
                    for (int k = 0; k < 4; ++k) sacc = sacc + cwv[k] * rows[i + k];
                    const int tok = tk0 + i;
                    uint2 w; w.x = pack2(sacc[0], sacc[1]); w.y = pack2(sacc[2], sacc[3]);
                    *(uint2*)(XCb + tok * 128 + ((((c4 >> 3) ^ ((tok >> 1) & 7))) << 4) + (c4 & 7) * 2) = w;
                }
                {
                    const int scn = sci + 1 < nsc ? sci + 1 : sci;
                    const int t0n = (dir == 0 ? scn : nsc - 1 - scn) * 128;
#pragma unroll
                    for (int r = 0; r < 11; ++r) {
                        const int tt = t0n + tk0 + r - 2, ttc = tt < 0 ? 0 : (tt >= L ? L - 1 : tt);
                        const f32x4 v = *(const f32x4*)(P + (size_t)(rowbase + ttc) * 2048 + 768 + ch0 + c4);
                        rows[r] = (tt >= 0 && tt < L) ? v : (f32x4){0.f, 0.f, 0.f, 0.f};
                    }
                }
            }
            __syncthreads();
            for (int sbi = 0; sbi < 2; ++sbi) {
                const int sub = dir == 0 ? sbi : 1 - sbi;
                float gpre[16 * NCH / 64], hpre[16 * NCH / 64];
                if (dir == 1 && dsel < 0) {
#pragma unroll
                    for (int k = 0; k < 16 * NCH / 64; ++k) {
                        const int i = tid + 256 * k, tok = i / NCH, cch = ch0 + coff + (i % NCH);
                        const size_t row = rowbase + t0 + sub * 64 + tok;
                        gpre[k] = P[row * 2048 + 1280 + cch]; hpre[k] = HF[row * 512 + cch];
                    }
                }
                f32x4 acc[2 * NT];
#pragma unroll
                for (int i = 0; i < 2 * NT; ++i) acc[i] = (f32x4){0.f, 0.f, 0.f, 0.f};
                const int trow = sub * 64 + wid * 16 + fr;
#pragma unroll
                for (int ks = 0; ks < 2; ++ks) {
                    const int chk = ((ks * 4 + fq) ^ sw) << 4;
                    const bf16x8 af = *(const bf16x8*)(XCb + trow * 128 + chk);
#pragma unroll
                    for (int ni = 0; ni < 2 * NT; ++ni) {
                        const bf16x8 bfr = *(const bf16x8*)(WT + (ni * 16 + fr) * 128 + chk);
                        acc[ni] = __builtin_amdgcn_mfma_f32_16x16x32_bf16(bfr, af, acc[ni], 0, 0, 0);
                    }
                }
                __syncthreads();
#pragma unroll
                for (int nc = 0; nc < NT; ++nc) {
                    const int cl = nc * 16 + fq * 4;
                    const int cc = coff + cl;
                    const f32x4 brv = *(const f32x4*)(CN + cl), biv = *(const f32x4*)(CN + NCH + cl), spv = *(const f32x4*)(CN + 2 * NCH + cl);
                    const uint2 xw = *(const uint2*)(XCb + trow * 128 + ((((cc >> 3) ^ ((trow >> 1) & 7))) << 4) + (cc & 7) * 2);
                    const float xv[4] = {__uint_as_float(xw.x << 16), __uint_as_float(xw.x & 0xffff0000u), __uint_as_float(xw.y << 16), __uint_as_float(xw.y & 0xffff0000u)};
                    f32x4 av, uv;
#pragma unroll
                    for (int jj = 0; jj < 4; ++jj) {
                        const float r = sigmoidf_(acc[nc][jj] + brv[jj]), gi = sigmoidf_(acc[NT + nc][jj] + biv[jj]);
                        const float la = -8.0f * r * spv[jj];
                        const float aa = __expf(la);
                        av[jj] = aa;
                        uv[jj] = sqrtf(fmaxf(1.0f - aa * aa, 0.f)) * gi * xv[jj];
                    }
                    *(f32x4*)(Al + (wid * 16 + fr) * AS + cl) = av;
                    *(f32x4*)(Ul + (wid * 16 + fr) * AS + cl) = uv;
                }
                __syncthreads();
                if (tid < NCH) {
                    for (int s8 = 0; s8 < 64; s8 += 8) {
                        float a8[8], u8[8];
#pragma unroll
                        for (int e = 0; e < 8; ++e) { const int tok = dir == 0 ? s8 + e : 63 - (s8 + e); a8[e] = Al[tok * AS + tid]; u8[e] = Ul[tok * AS + tid]; }
#pragma unroll
                        for (int e = 0; e < 8; ++e) { hstate = a8[e] * hstate + u8[e]; u8[e] = hstate; }
#pragma unroll
                        for (int e = 0; e < 8; ++e) { const int tok = dir == 0 ? s8 + e : 63 - (s8 + e); Ul[tok * AS + tid] = u8[e]; }
                    }
                }
                __syncthreads();
#pragma unroll
                for (int k = 0; k < 16 * NCH / 64; ++k) {
                    const int i = tid + 256 * k;
                    const int tok = i / NCH, cl = i % NCH, cch = ch0 + coff + cl;
                    const size_t row = rowbase + t0 + sub * 64 + tok;
                    const float hv = Ul[tok * AS + cl];
                    if (dir == 0) HF[row * 512 + cch] = hv;
                    else if (dsel >= 0) HB[row * 512 + cch] = hv;
                    else MIX[row * 1024 + 512 + cch] = f2bf((hpre[k] + hv) * gelu_fast(gpre[k]));
                }
            }
        }
        if (!latent && tid < NCH) p.out[OUT_LRU + ((size_t)(b * 2 + jl) * 2 + dir) * 512 + ch0 + coff + tid] = hstate;
    }
    if (dsel >= 0) {
        volatile int* slot = (volatile int*)(lds + LDS_BYTES - 28);
        unsigned* cnt = (unsigned*)(ws + OFF_CTL + 14336 + 256) + jl * 64 + ((b * 8 + hb) * (64 / NCH) + coff / NCH);
        asm volatile("s_waitcnt vmcnt(0)" ::: "memory");
        __syncthreads();
        if (tid == 0) {
            __builtin_amdgcn_fence(__ATOMIC_RELEASE, "agent");
            asm volatile("s_waitcnt vmcnt(0)" ::: "memory");
            const unsigned old = __hip_atomic_fetch_add(cnt, 1u, __ATOMIC_RELAXED, __HIP_MEMORY_SCOPE_AGENT);
            __builtin_amdgcn_fence(__ATOMIC_ACQUIRE, "agent");
            asm volatile("s_waitcnt vmcnt(0)" ::: "memory");
            *slot = (int)old;
        }
        __syncthreads();
        if (*slot == 1) {
            for (int i = tid; i < L * NCH; i += 256) {
                const int tok = i / NCH, cch = ch0 + coff + (i % NCH);
                const size_t row = rowbase + tok;
                const float gg = __builtin_nontemporal_load(P + row * 2048 + 1280 + cch);
                MIX[row * 1024 + 512 + cch] = f2bf((__builtin_nontemporal_load(HF + row * 512 + cch) + __builtin_nontemporal_load(HB + row * 512 + cch)) * gelu_fast(gg));
            }
        }
    }
}

DEV void phase_even_mixer(const Params& p, int l, unsigned char* lds, unsigned* ctr) {
    const int jl = l >> 1;
    for (;;) {
        const int u = wq_next(ctr, lds);
        if (u >= (l == 0 ? 1280 + 256 + 348 : 1280)) break;
        if (u >= 1536) { sw_unit(p, u - 1536 + 28, lds); continue; }
        if (u >= 1280) { filter_unit(p, u - 1280, lds); continue; }
        if (u < 128) lru_unit<16>(p, jl, 1, u >> 6, (u >> 3) & 7, ((u >> 1) & 3) * 16, lds, u & 1);
        else if (u < 256) { const int uu = u - 128; attn_unit(p, jl, 1, uu >> 6, (uu >> 5) & 1, uu & 31, lds); }
        else if (u < 768) { const int uu = u - 256; lru_unit<32>(p, jl, 0, uu >> 4, (uu >> 1) & 7, (uu & 1) * 32, lds, -1); }
        else { const int uu = u - 768; attn_unit(p, jl, 0, uu >> 4, (uu >> 3) & 1, uu & 7, lds); }
    }
}

template <int L, int NBAT>
DEV void hyena_unit(const Params& p, int j, int c, int bg, unsigned char* lds) {
    unsigned char* ws = p.ws;
    constexpr int LAT = (L == 1024) ? 1 : 0;
    constexpr int MIW = LAT ? 2 : L / 64, ZS = LAT ? 2576 : 2 * L + 16, ZOFF = LAT ? 256 : 0, FS = LAT ? 4416 : 4 * L + 64  ;
    constexpr int CHK = LAT ? 264 : L / 4  , NKS = LAT ? 36 : L / 32, MSTEP = LAT ? 128 : 16;
    const int tid = TIDX, lane = tid & 63, wid = tid >> 6, fr = lane & 15, fq = lane >> 4;
    unsigned char* Zb = lds; unsigned char* X1b = Zb + NBAT * ZS; unsigned char* X2b = X1b + NBAT * ZS; unsigned char* FC = X2b + NBAT * ZS;
    const int rowbase0 = LAT ? MCTX : bg * 16 * 256;
    const bf16_t* PT = (const bf16_t*)(ws + OFF_HU);
    const float* TFb = (const float*)(ws + OFF_TF + (size_t)j * 10 * MiB + (LAT ? 2 * MiB : 0));
    const float* cw = p.in[26] + j * 3 * 1536; const float* cb = p.in[27] + j * 1536;
    __syncthreads();
    float* STG = (float*)(FC + (size_t)(LAT ? 1 : 2) * 8 * FS);
    auto stage = [&](int n, int sslot) {
        const float* Rv = TFb + ((size_t)n * 512 + c) * (2 * L);
        const float rsn = ((const float*)(ws + OFF_HID + 655360))[((j * 2 + LAT) * 2 + n) * 512 + c];
        for (int i = tid; i < 2 * L / 4; i += 256) *(f32x4*)(STG + sslot * 2 * L + i * 4) = *(const f32x4*)(Rv + i * 4) * rsn;
    };
    auto build = [&](int sslot, int slot) {
        const float* R = STG + sslot * 2 * L;
        for (int q = tid; q < 8 * CHK; q += 256) {
            const int sft = q / CHK, x = (q % CHK) * 8;
            float v[8];
#pragma unroll
            for (int e = 0; e < 8; ++e) { const int y = x + sft + e; const float rvv = R[y < 2 * L ? y : 2 * L - 1]; v[e] = y < 2 * L ? rvv : 0.f; }
            u32x4 w; w.x = pack2(v[0], v[1]); w.y = pack2(v[2], v[3]); w.z = pack2(v[4], v[5]); w.w = pack2(v[6], v[7]);
            *(u32x4*)(FC + (size_t)slot * 8 * FS + sft * FS + x * 2) = w;
        }
    };
    if (LAT && tid < 64) {
        const int zr = tid >> 5, side = (tid >> 4) & 1, off = (tid & 15) * 16;
        const unsigned z0 = (unsigned)tid >> 31;
        *(u32x4*)(Zb + zr * ZS + (side ? ZOFF + 2 * L : 0) + off) = (u32x4){z0, z0, z0, z0};
    }
    stage(0, 0);
    stage(1, 1);
    __syncthreads();
    build(0, 0);
    if (!LAT) build(1, 1);
#pragma unroll
    for (int st = 0; st < 3; ++st) {
        const int ch3 = st * 512 + c;
        const float w0 = cw[ch3], w1 = cw[1536 + ch3], w2 = cw[2 * 1536 + ch3], bb0 = cb[ch3];
        unsigned char* dstb = st == 0 ? Zb : (st == 1 ? X1b : X2b);
        for (int q = tid; q < NBAT * L / 8; q += 256) {
            const int bb = q / (L / 8), t0 = (q % (L / 8)) * 8;
            const bf16_t* src = PT + (size_t)ch3 * MROWS + rowbase0 + bb * L + t0;
            const u32x4 raw = __builtin_nontemporal_load((const u32x4*)src);
            float x[10];
            { const bf16_t pv = src[t0 > 0 ? -1 : 0], nv = src[t0 + 8 < L ? 8 : 7]; x[0] = t0 > 0 ? bf2f(pv) : 0.f; x[9] = t0 + 8 < L ? bf2f(nv) : 0.f; }
            x[1] = __uint_as_float(raw.x << 16); x[2] = __uint_as_float(raw.x & 0xffff0000u);
            x[3] = __uint_as_float(raw.y << 16); x[4] = __uint_as_float(raw.y & 0xffff0000u);
            x[5] = __uint_as_float(raw.z << 16); x[6] = __uint_as_float(raw.z & 0xffff0000u);
            x[7] = __uint_as_float(raw.w << 16); x[8] = __uint_as_float(raw.w & 0xffff0000u);
            float o[8];
#pragma unroll
            for (int e = 0; e < 8; ++e) o[e] = bb0 + w0 * x[e] + w1 * x[e + 1] + w2 * x[e + 2];
            u32x4 w; w.x = pack2(o[0], o[1]); w.y = pack2(o[2], o[3]); w.z = pack2(o[4], o[5]); w.w = pack2(o[6], o[7]);
            *(u32x4*)(dstb + bb * ZS + ZOFF + t0 * 2) = w;
        }
    }
    __syncthreads();
    const int brow = NBAT == 16 ? fr : (fr & 1);
    const int sft = 7 - (fr & 7);
    bf16_t* ZT = (bf16_t*)(ws + OFF_XG);
#pragma unroll
    for (int ord = 0; ord < 2; ++ord) {
        const unsigned char* FCn = FC + (size_t)(LAT ? 0 : ord) * 8 * FS + sft * FS;
        f32x4 acc[MIW];
#pragma unroll
        for (int mi = 0; mi < MIW; ++mi) acc[mi] = (f32x4){0.f, 0.f, 0.f, 0.f};
        const int i00 = LAT ? 112 + wid * MIW * MSTEP : wid * MIW * MSTEP;
        const unsigned char* abase = FCn + (L - 8 - i00 - (fr & 8) + fq * 8) * 2;
        const unsigned char* bbase = LAT ? Zb + (fr >> 3) * ZS + ZOFF + (fq * 8 - 16 * (fr & 7)) * 2 : Zb + brow * ZS + fq * 16;
#pragma unroll 2
        for (int ks = 0; ks < NKS; ++ks) {
            const bf16x8 bfrag = *(const bf16x8*)(bbase + ks * 64);
            bf16x8 af[MIW];
#pragma unroll
            for (int mi = 0; mi < MIW; ++mi) af[mi] = *(const bf16x8*)(abase + ks * 64 - mi * MSTEP * 2);
#pragma unroll
            for (int mi = 0; mi < MIW; ++mi) acc[mi] = __builtin_amdgcn_mfma_f32_16x16x32_bf16(af[mi], bfrag, acc[mi], 0, 0, 0);
            __builtin_amdgcn_sched_group_barrier(0x100, MIW + 1, 0);
            __builtin_amdgcn_sched_group_barrier(0x008, MIW, 0);
        }
        const float hb = p.in[35][(j * 2 + ord) * 512 + c];
        if (ord == 0) {
            __syncthreads();
            {
                const int eb = LAT ? (fr >> 3) : fr;
#pragma unroll
                for (int mi = 0; mi < MIW; ++mi) {
                    const int t = i00 + mi * MSTEP + fq * 4 - (LAT ? 16 * (fr & 7) : 0);
                    const uint2 zr = *(const uint2*)(Zb + eb * ZS + ZOFF + t * 2), xr = *(const uint2*)(X1b + eb * ZS + ZOFF + t * 2);
                    const float z[4] = {__uint_as_float(zr.x << 16), __uint_as_float(zr.x & 0xffff0000u), __uint_as_float(zr.y << 16), __uint_as_float(zr.y & 0xffff0000u)};
                    const float g[4] = {__uint_as_float(xr.x << 16), __uint_as_float(xr.x & 0xffff0000u), __uint_as_float(xr.y << 16), __uint_as_float(xr.y & 0xffff0000u)};
                    float o[4];
#pragma unroll
                    for (int e = 0; e < 4; ++e) o[e] = g[e] * (acc[mi][e] + hb * z[e]);
                    uint2 w; w.x = pack2(o[0], o[1]); w.y = pack2(o[2], o[3]);
                    *(uint2*)(Zb + eb * ZS + ZOFF + t * 2) = w;
                }
            }
            if (LAT) build(1, 0);
            __syncthreads();
        } else {
            {
                const int eb = LAT ? (fr >> 3) : fr;
#pragma unroll
                for (int mi = 0; mi < MIW; ++mi) {
                    const int t = i00 + mi * MSTEP + fq * 4 - (LAT ? 16 * (fr & 7) : 0);
                    const uint2 zr = *(const uint2*)(Zb + eb * ZS + ZOFF + t * 2), xr = *(const uint2*)(X2b + eb * ZS + ZOFF + t * 2);
                    const float z[4] = {__uint_as_float(zr.x << 16), __uint_as_float(zr.x & 0xffff0000u), __uint_as_float(zr.y << 16), __uint_as_float(zr.y & 0xffff0000u)};
                    const float g[4] = {__uint_as_float(xr.x << 16), __uint_as_float(xr.x & 0xffff0000u), __uint_as_float(xr.y << 16), __uint_as_float(xr.y & 0xffff0000u)};
                    float o[4];
#pragma unroll
                    for (int e = 0; e < 4; ++e) o[e] = g[e] * (acc[mi][e] + hb * z[e]);
                    uint2 w; w.x = pack2(o[0], o[1]); w.y = pack2(o[2], o[3]);
                    *(uint2*)(ZT + (size_t)c * MROWS + rowbase0 + eb * L + t) = w;
                }
            }
        }
    }
}

DEV void phase_odd1(const Params& p, int l, unsigned char* lds, unsigned* ctr) {
    unsigned char* ws = p.ws;
    const int j = l >> 1;
    for (;;) {
        const int u = wq_next(ctr, lds);
        if (u >= 2176) break;
        if (u < 512) { hyena_unit<1024, 2>(p, j, u, 0, lds); if (REP(13) > 1) hyena_unit<1024, 2>(p, j, u, 0, lds); }
        else if (u < 1536) { const int uu = u - 512; hyena_unit<256, 16>(p, j, uu >> 1, uu & 1, lds); if (REP(14) > 1) hyena_unit<256, 16>(p, j, uu >> 1, uu & 1, lds); }
        else {
            int latent, b, g, tm, tn, L;
            if (u < 1664) { const int uu = u - 1536; latent = 1; L = 1024; b = uu >> 6; g = (uu >> 4) & 3; tm = (uu >> 3) & 1; tn = uu & 7; }
            else { const int uu = u - 1664; latent = 0; L = 256; b = uu >> 4; g = (uu >> 2) & 3; tm = (uu >> 1) & 1; tn = uu & 1; }
            const int rowbase = latent ? MCTX + b * 1024 : b * 256;
            EpiF1 epi; epi.L = L; epi.g = g;
            epi.FT = (bf16_t*)(ws + OFF_FT) + (latent ? (size_t)32 * 512 * 512 + (size_t)b * 512 * 2048 : (size_t)b * 512 * 512);
            __syncthreads();
            gemm_tile<128>((const bf16_t*)(ws + OFF_CS128), 128, (const bf16_t*)(ws + OFF_PF) + (size_t)rowbase * 512 + g * 128, 512, 128, tm * 128, tn * 128, lds, epi);
        }
    }
}
DEV void phase_odd2(const Params& p, int l, unsigned char* lds, int vb, int G) {
    unsigned char* ws = p.ws;
    for (int it = 0;; ++it) {
        int u;
        if (G == 512) {
            if (it == 0) { if (vb >= 384) continue; u = vb; }
            else { const int ux = (vb - 128) + (it - 1) * 384; if (vb < 128 || ux >= 1280) break; u = 384 + ux; }
        } else { u = vb + it * G; if (u >= 1664) break; }
        if (u >= 384) {
            const int uu = u - 384, c0 = (uu & 7) * 64, r0 = (uu >> 3) * 64;
            const int tid = TIDX;
            const bf16_t* ZT = (const bf16_t*)(ws + OFF_XG);
            bf16_t* MIXp = (bf16_t*)(ws + OFF_MIX);
            __syncthreads();
            {
                const int cc = tid >> 2, part = tid & 3;
                const u32x4* src = (const u32x4*)(ZT + (size_t)(c0 + cc) * MROWS + r0 + part * 16);
                const u32x4 a0 = src[0], a1 = src[1];
                *(u32x4*)(lds + cc * 144 + part * 32) = a0;
                *(u32x4*)(lds + cc * 144 + part * 32 + 16) = a1;
            }
            __syncthreads();
            {
                const int rr = tid >> 2, part = tid & 3;
                unsigned w[8];
#pragma unroll
                for (int e = 0; e < 8; ++e) {
                    const unsigned lo = *(const bf16_t*)(lds + (part * 16 + 2 * e) * 144 + rr * 2);
                    const unsigned hi = *(const bf16_t*)(lds + (part * 16 + 2 * e + 1) * 144 + rr * 2);
                    w[e] = lo | (hi << 16);
                }
                u32x4* dst = (u32x4*)(MIXp + (size_t)(r0 + rr) * 1024 + 512 + c0 + part * 16);
                dst[0] = (u32x4){w[0], w[1], w[2], w[3]};
                dst[1] = (u32x4){w[4], w[5], w[6], w[7]};
            }
            continue;
        }
        if (u < 128) {
            const int b = u >> 6, tm = (u >> 3) & 7, tn = u & 7;
            EpiF2 epi; epi.MIX = (bf16_t*)(ws + OFF_MIX); epi.rowbase = MCTX + b * 1024;
            __syncthreads();
            gemm_tile<64>((const bf16_t*)(ws + OFF_CSL1024), 2048, (const bf16_t*)(ws + OFF_FT) + (size_t)32 * 512 * 512 + (size_t)b * 512 * 2048, 2048, 2048, tm * 128, tn * 64, lds, epi);
        } else {
            const int uu = u - 128, b = uu >> 3, tm = (uu >> 2) & 1, tn = uu & 3;
            EpiF2 epi; epi.MIX = (bf16_t*)(ws + OFF_MIX); epi.rowbase = b * 256;
            __syncthreads();
            gemm_tile<128>((const bf16_t*)(ws + OFF_CSL256), 512, (const bf16_t*)(ws + OFF_FT) + (size_t)b * 512 * 512, 512, 512, tm * 128, tn * 128, lds, epi);
        }
    }
}

DEV void phase_final(const Params& p, int vb, int G) {
    unsigned char* ws = p.ws;
    const float* X = (const float*)(ws + OFF_X);
    const float* SSQ = (const float*)(ws + OFF_SSQ) + (size_t)8 * 16 * MROWS;
    const int lane = TIDX & 63;
    for (int u = vb; u < 640; u += G) {
        const int r0 = u * 16 + (TIDX >> 6) * 4;
        for (int rr = 0; rr < 4; ++rr) {
            const int row = r0 + rr;
            float s = lane < 16 ? SSQ[(size_t)lane * MROWS + row] : 0.f;
#pragma unroll
            for (int o = 8; o >= 1; o >>= 1) s += __shfl_xor(s, o);
            s = __shfl(s, 0);
            const float rs = rsqrtf(s * (1.0f / 1024.0f) + 1e-6f);
#pragma unroll
            for (int i = 0; i < 4; ++i) {
                const int col = lane * 4 + i * 256;
                const f32x4 x = __builtin_nontemporal_load((const f32x4*)(X + (size_t)row * 1024 + col));
                const f32x4 w4 = *(const f32x4*)(p.in[11] + col);
                *(f32x4*)(p.out + (size_t)row * 1024 + col) = x * rs * w4;
            }
        }
    }
}


#define XB_TMO      128
#define XB_XCNT(j)  (256  + 64 * (j))
#define XB_XSUB(j)  (1280 + 64 * (j))
#define XB_XGEN(j)  (2304 + 64 * (j))
#define XB_TOP      3328
#define XB_TOPGEN   3392
#define XCD_BAR_WORDS 3456
#define XB_SPIN_CAP (1u << 18)
__device__ __forceinline__ unsigned xb_ld(unsigned* p)              { return __hip_atomic_load(p, __ATOMIC_RELAXED, __HIP_MEMORY_SCOPE_AGENT); }
__device__ __forceinline__ unsigned xb_add(unsigned* p, unsigned v) { return __hip_atomic_fetch_add(p, v, __ATOMIC_RELAXED, __HIP_MEMORY_SCOPE_AGENT); }
__device__ __forceinline__ unsigned xb_xcc_id() { return (unsigned)__builtin_amdgcn_s_getreg((3 << 11) | 20) & 0xFu; }
#define XB_SPIN(cond, bar) do { unsigned _sp = 0; while (cond) { __builtin_amdgcn_s_sleep(1); \
    if ((++_sp & 255u) == 0u) { if (xb_ld(&(bar)[XB_TMO])) break; if (_sp > XB_SPIN_CAP) { atomicAdd(&(bar)[XB_TMO], 1u); break; } } } } while (0)
struct XcdBarrier { unsigned* bar; unsigned x; volatile unsigned* st; };
__device__ __forceinline__ XcdBarrier xcd_barrier_post(unsigned* bar, volatile unsigned* st) {
    XcdBarrier b; b.bar = bar; b.x = xb_xcc_id(); b.st = st;
    if (threadIdx.x == 0) (void)xb_add(&bar[XB_XCNT(b.x)], 1u);
    return b;
}
__device__ __forceinline__ void xcd_barrier_complete(unsigned* bar, unsigned x, unsigned& nloc, unsigned& nx) {
    const unsigned G = gridDim.x * gridDim.y * gridDim.z;
    unsigned sum, cnt, mine, sp = 0u;
    for (;;) {
        sum = 0u; cnt = 0u; mine = 0u;
#pragma unroll
        for (unsigned j = 0; j < 16; ++j) { const unsigned c = xb_ld(&bar[XB_XCNT(j)]); sum += c; cnt += (c > 0u) ? 1u : 0u; mine = (j == x) ? c : mine; }
        if (sum == G) break;
        __builtin_amdgcn_s_sleep(1);
        if ((++sp & 255u) == 0u) { if (xb_ld(&bar[XB_TMO])) break; if (sp > XB_SPIN_CAP) { atomicAdd(&bar[XB_TMO], 1u); break; } }
    }
    nloc = mine > 0u ? mine : 1u; nx = cnt > 0u ? cnt : 1u;
}
__device__ __forceinline__ void xcd_barrier(const XcdBarrier& b) {
    asm volatile("s_waitcnt vmcnt(0)" ::: "memory");
    __syncthreads();
    if (threadIdx.x == 0) {
        unsigned* bar = b.bar;
        __builtin_amdgcn_s_waitcnt(0);
        unsigned nloc = b.st[0], nx = b.st[1];
        if (nloc == 0u) { xcd_barrier_complete(bar, b.x, nloc, nx); b.st[0] = nloc; b.st[1] = nx; }
        const unsigned old = xb_add(&bar[XB_XSUB(b.x)], 1u);
        const unsigned gen = old / nloc;
        if (old + 1u == (gen + 1u) * nloc) {
            __builtin_amdgcn_fence(__ATOMIC_RELEASE, "agent");
            asm volatile("s_waitcnt vmcnt(0)" ::: "memory");
            const unsigned og = xb_add(&bar[XB_TOP], 1u);
            const unsigned tg = og / nx;
            if (og + 1u == (tg + 1u) * nx) xb_add(&bar[XB_TOPGEN], 1u);
            else XB_SPIN(xb_ld(&bar[XB_TOPGEN]) == tg, bar);
            __builtin_amdgcn_fence(__ATOMIC_ACQUIRE, "agent");
            xb_add(&bar[XB_XGEN(b.x)], 1u);
            asm volatile("s_waitcnt vmcnt(0)" ::: "memory");
        } else {
            XB_SPIN(xb_ld(&bar[XB_XGEN(b.x)]) == gen, bar);
            __builtin_amdgcn_fence(__ATOMIC_ACQUIRE, "agent");
            asm volatile("s_waitcnt vmcnt(0)" ::: "memory");
        }
    }
    __syncthreads();
}

#ifndef ONLY
#define ONLY -1
#endif
#define EN(x) (ONLY < 0 || ONLY == (x))
DEV void run_phase(const Params& p, int ph, unsigned char* lds, int vb, int G) {
    if (ph == 0) { if (EN(0)) for (int r_ = 0; r_ < REP(0); ++r_) phase_prepA(p, lds, vb, G); return; }
    if (ph == 1) { if (EN(1)) for (int r_ = 0; r_ < REP(1); ++r_) phase_prepB(p, lds, vb, G); return; }
    if (ph == 24) { if (EN(2)) for (int r_ = 0; r_ < REP(2); ++r_) phase_final(p, vb, G); return; }
    int q = ph - 2, l;
    if (q < 5) l = 0; else if (q < 11) { l = 1; q -= 5; } else if (q < 16) { l = 2; q -= 11; } else { l = 3; q -= 16; }
    if (!(l & 1)) {
        switch (q) {
            case 0: if (EN(3)) for (int r_ = 0; r_ < REP(3); ++r_) phase_gemm_in(p, l, lds, vb, G); break;
            case 1: if (EN(4)) for (int r_ = 0; r_ < REP(4); ++r_) phase_even_mixer(p, l, lds, (unsigned*)(p.ws + OFF_CTL + 16384) + (ph * 2 + r_) * 512); break;
            case 2: if (EN(5)) for (int r_ = 0; r_ < REP(11); ++r_) phase_gemm_res(p, l, 0, lds, vb, G, r_ ? 0.f : 1.f); break;
            case 3: if (EN(6)) for (int r_ = 0; r_ < REP(6); ++r_) phase_gemm_mlp1(p, l, lds, vb, G); break;
            default: if (EN(5)) for (int r_ = 0; r_ < REP(12); ++r_) phase_gemm_res(p, l, 1, lds, vb, G, r_ ? 0.f : 1.f); break;
        }
    } else {
        switch (q) {
            case 0: if (EN(3)) for (int r_ = 0; r_ < REP(3); ++r_) phase_gemm_in(p, l, lds, vb, G); break;
            case 1: if (EN(7)) for (int r_ = 0; r_ < REP(7); ++r_) phase_odd1(p, l, lds, (unsigned*)(p.ws + OFF_CTL + 16384) + (ph * 2 + r_) * 512); break;
            case 2: if (EN(8)) for (int r_ = 0; r_ < REP(8); ++r_) phase_odd2(p, l, lds, vb, G); break;
            case 3: if (EN(5)) for (int r_ = 0; r_ < REP(11); ++r_) phase_gemm_res(p, l, 0, lds, vb, G, r_ ? 0.f : 1.f); break;
            case 4: if (EN(6)) for (int r_ = 0; r_ < REP(6); ++r_) phase_gemm_mlp1(p, l, lds, vb, G); break;
            default: if (EN(5)) for (int r_ = 0; r_ < REP(12); ++r_) phase_gemm_res(p, l, 1, lds, vb, G, r_ ? 0.f : 1.f); break;
        }
    }
}

__global__ void __launch_bounds__(256, 2) hybrid_fwd(Params p, int ph_lo, int ph_hi) {
    extern __shared__ __attribute__((aligned(16))) unsigned char lds[];
    const int G = gridDim.x;
    const int vb = (G & 7) == 0 ? (blockIdx.x & 7) * (G >> 3) + (blockIdx.x >> 3) : blockIdx.x;
#if N_LAUNCH_SPLIT
    for (int ph = ph_lo; ph < ph_hi; ++ph) run_phase(p, ph, lds, vb, G);
#else
    cg::grid_group grid = cg::this_grid();
    volatile unsigned* st = (volatile unsigned*)(lds + LDS_BYTES - 16);
    if (threadIdx.x == 0) { st[0] = 0u; st[1] = 0u; }
    __syncthreads();
    XcdBarrier xb = xcd_barrier_post((unsigned*)(p.ws + OFF_CTL), st);
    if (ph_lo < 0) grid.sync();
    for (int ph = ph_lo; ph < ph_hi; ++ph) {
        run_phase(p, ph, lds, vb, G);
        if (ph + 1 < ph_hi) { xcd_barrier(xb); for (int r_ = 1; r_ < REP(10); ++r_) xcd_barrier(xb); }
    }
#endif
}

extern "C" void kernel_launch(void* const* d_in, const int* in_sizes, int n_in, void* d_out, int out_size, void* d_ws, size_t ws_size, hipStream_t stream) {
    static int grid = 0;
    if (grid == 0) {
        if (n_in != 36 || ws_size < WS_END) { fprintf(stderr, "kernel_launch: need 36 inputs and >= %zu bytes of workspace (got %d, %zu)\n", (size_t)WS_END, n_in, ws_size); grid = -1; return; }
        int dev = 0, cus = 0, per_cu = 0;
        hipGetDevice(&dev);
        hipDeviceGetAttribute(&cus, hipDeviceAttributeMultiprocessorCount, dev);
        hipFuncSetAttribute((const void*)hybrid_fwd, hipFuncAttributeMaxDynamicSharedMemorySize, LDS_BYTES);
        hipOccupancyMaxActiveBlocksPerMultiprocessor(&per_cu, (const void*)hybrid_fwd, 256, LDS_BYTES);
        if (per_cu < 1) per_cu = 1;
        if (per_cu > 2) per_cu = 2;
        grid = cus * per_cu;
        fprintf(stderr, "kernel_launch: grid %d (%d CUs x %d)\n", grid, cus, per_cu);
    }
    if (grid < 0) return;
    Params p{};
    for (int i = 0; i < 36; ++i) p.in[i] = (const float*)d_in[i];
    p.out = (float*)d_out; p.ws = (unsigned char*)d_ws;
#if N_LAUNCH_SPLIT
    for (int ph = 0; ph < NPHASE; ++ph) hipLaunchKernelGGL(hybrid_fwd, dim3(grid), dim3(256), LDS_BYTES, stream, p, ph, ph + 1);
#else
    if (hipMemsetAsync((char*)d_ws + OFF_CTL, 0, CTL_BYTES, stream) != hipSuccess) { fprintf(stderr, "kernel_launch: memset of control words failed\n"); return; }
    int lo = 0, hi = NPHASE;
    void* args[] = {&p, &lo, &hi};
    hipError_t e = hipLaunchCooperativeKernel((const void*)hybrid_fwd, dim3(grid), dim3(256), args, LDS_BYTES, stream);
    if (e != hipSuccess) fprintf(stderr, "cooperative launch failed: %s (grid %d)\n", hipGetErrorString(e), grid);
#endif
}
```

```cpp
#include <hip/hip_runtime.h>
#include <hip/hip_cooperative_groups.h>
#include <cstdio>
#include <cstdint>
namespace cg = cooperative_groups;

typedef unsigned short bf16_t;
typedef short bf16x8 __attribute__((ext_vector_type(8)));
typedef short s16x4 __attribute__((ext_vector_type(4)));
typedef float f32x4 __attribute__((ext_vector_type(4)));
typedef unsigned u32x4 __attribute__((ext_vector_type(4)));
#define DEV __device__ __forceinline__
__device__ __forceinline__ int tid_launder() { int t = (int)threadIdx.x; asm volatile("" : "+v"(t)); return t; }
#define TIDX tid_launder()

#ifndef PROBE_MASK
#define PROBE_MASK 0
#endif
#define REP(x) ((((PROBE_MASK) >> (x)) & 1) + 1)
#ifndef N_LAUNCH_SPLIT
#define N_LAUNCH_SPLIT 0
#endif

constexpr int MROWS = 10240, MCTX = 8192, DM = 1024;
constexpr int LDS_BYTES = 72 * 1024;
constexpr int NPHASE = 25;

struct Params { const float* in[36]; float* out; unsigned char* ws; };

constexpr size_t MiB = 1ull << 20;
constexpr size_t OFF_WTIN  = 0;
constexpr size_t OFF_WTOUT = OFF_WTIN + 16 * MiB;
constexpr size_t OFF_WT1   = OFF_WTOUT + 8 * MiB;
constexpr size_t OFF_WT2   = OFF_WT1 + 32 * MiB;
constexpr size_t OFF_MOD   = OFF_WT2 + 32 * MiB;
constexpr size_t OFF_SWIN  = OFF_MOD + 1 * MiB;
constexpr size_t OFF_SW1   = OFF_SWIN + 256 * 1024;
constexpr size_t OFF_CS128 = OFF_SW1 + 256 * 1024;
constexpr size_t OFF_CSL256 = OFF_CS128 + 65536;
constexpr size_t OFF_ROPE  = OFF_CSL256 + 262144;
constexpr size_t OFF_HID   = OFF_ROPE + 8192;
constexpr size_t OFF_CSL1024 = OFF_HID + 655360 + 32768;
constexpr size_t OFF_TF    = OFF_CSL1024 + 4 * MiB;
constexpr size_t OFF_X     = OFF_TF + 20 * MiB;
constexpr size_t OFF_XG    = OFF_X + 40 * MiB;
constexpr size_t OFF_SSQ   = OFF_XG + 20 * MiB;
constexpr size_t OFF_P     = OFF_SSQ + 6 * MiB;
constexpr size_t OFF_HU    = OFF_P + 80 * MiB;
constexpr size_t OFF_PF    = OFF_HU + 60 * MiB;
constexpr size_t OFF_MIX   = OFF_PF + 10 * MiB;
constexpr size_t OFF_FT    = OFF_MIX + 20 * MiB;
constexpr size_t OFF_CTL   = OFF_FT + 20 * MiB;
constexpr size_t CTL_BYTES = 16384 + 131072;
constexpr size_t WS_END    = OFF_CTL + CTL_BYTES;

constexpr size_t OUT_YS = 8388608, OUT_K = 10485760, OUT_V = 12582912, OUT_LRU = 14680064;

DEV bf16_t f2bf(float f) { unsigned u = __float_as_uint(f); u += 0x7fffu + ((u >> 16) & 1u); return (bf16_t)(u >> 16); }
DEV unsigned pack2(float a, float b) { return (unsigned)f2bf(a) | ((unsigned)f2bf(b) << 16); }
DEV int vec_of_row(int row) { return row < MCTX ? 0 : 1 + ((row - MCTX) >> 10); }
DEV float sigmoidf_(float x) { return 1.0f / (1.0f + __expf(-x)); }


DEV int wq_next(unsigned* ctr, unsigned char* lds) {
    volatile int* slot = (volatile int*)(lds + LDS_BYTES - 32);
    __syncthreads();
    if (threadIdx.x == 0) { const unsigned x = blockIdx.x & 7u; *slot = (int)(__hip_atomic_fetch_add(ctr + x * 64, 1u, __ATOMIC_RELAXED, __HIP_MEMORY_SCOPE_AGENT) * 8u + x); }
    __syncthreads();
    return *slot;
}
template <int NB>
DEV void g_load(u32x4 (&ra)[4], u32x4 (&rb)[NB], const u32x4* Ag, const u32x4* Bg, size_t sa, size_t sb, int kt) {
#pragma unroll
    for (int i = 0; i < 4; ++i) ra[i] = Ag[i * sa + (size_t)kt * 8];
#pragma unroll
    for (int i = 0; i < NB; ++i) rb[i] = Bg[i * sb + (size_t)kt * 8];
}
template <int NB>
DEV void g_write(const u32x4 (&ra)[4], const u32x4 (&rb)[NB], unsigned char* base) {
#pragma unroll
    for (int i = 0; i < 4; ++i) *(u32x4*)(base + i * 4096) = ra[i];
#pragma unroll
    for (int i = 0; i < NB; ++i) *(u32x4*)(base + 16384 + i * 4096) = rb[i];
}
template <int MI, bool TRANS>
DEV void g_compute(f32x4 (&acc)[MI][4], const unsigned char* pa, const unsigned char* pb, int fq, int sw) {
#pragma unroll
    for (int ks = 0; ks < 2; ++ks) {
        bf16x8 af[MI], bfr[4];
        const int ch = ((ks * 4 + fq) ^ sw) << 4;
#pragma unroll
        for (int mi = 0; mi < MI; ++mi) af[mi] = *(const bf16x8*)(pa + mi * 2048 + ch);
#pragma unroll
        for (int ni = 0; ni < 4; ++ni) bfr[ni] = *(const bf16x8*)(pb + ni * 2048 + ch);
#pragma unroll
        for (int mi = 0; mi < MI; ++mi)
#pragma unroll
            for (int ni = 0; ni < 4; ++ni) acc[mi][ni] = TRANS ? __builtin_amdgcn_mfma_f32_16x16x32_bf16(af[mi], bfr[ni], acc[mi][ni], 0, 0, 0)
                                                               : __builtin_amdgcn_mfma_f32_16x16x32_bf16(bfr[ni], af[mi], acc[mi][ni], 0, 0, 0);
    }
}
template <int BN, class Epi, bool TRANS = false>
DEV void gemm_tile(const bf16_t* __restrict__ A, int lda, const bf16_t* __restrict__ Bt, int ldb, int K, int m0, int n0,
                   unsigned char* lds, const Epi& epi) {
    constexpr int MI = BN == 128 ? 4 : 2, NB = BN / 32;
    const int tid = TIDX, lane = tid & 63, wid = tid >> 6, fr = lane & 15, fq = lane >> 4;
    const int wr = BN == 128 ? (wid >> 1) : wid, wc = BN == 128 ? (wid & 1) : 0;
    const int rbase = wr * (MI * 16);
    f32x4 acc[MI][4];
#pragma unroll
    for (int i = 0; i < MI; ++i)
#pragma unroll
        for (int j = 0; j < 4; ++j) acc[i][j] = (f32x4){0.f, 0.f, 0.f, 0.f};
    const int lrow = tid >> 3, lc = tid & 7;
    const u32x4* Ag = (const u32x4*)(A + (size_t)(m0 + lrow) * lda + lc * 8);
    const u32x4* Bg = (const u32x4*)(Bt + (size_t)(n0 + lrow) * ldb + lc * 8);
    const size_t sa = (size_t)4 * lda, sb = (size_t)4 * ldb;
    const int woff = lrow * 128 + ((lc ^ ((lrow >> 1) & 7)) << 4);
    const int sw = (fr >> 1) & 7;
    const int aoff = (rbase + fr) * 128, boff = 16384 + (wc * 64 + fr) * 128;
    u32x4 ra0[4], rb0[NB], ra1[4], rb1[NB];
    const int nk = K >> 6;
    g_load<NB>(ra0, rb0, Ag, Bg, sa, sb, 0);
    g_write<NB>(ra0, rb0, lds + woff);
    g_load<NB>(ra0, rb0, Ag, Bg, sa, sb, 1);
    __syncthreads();
    for (int kt = 0; kt < nk; kt += 2) {
        g_load<NB>(ra1, rb1, Ag, Bg, sa, sb, kt + 2 < nk ? kt + 2 : nk - 1);
        g_compute<MI, TRANS>(acc, lds + aoff, lds + boff, fq, sw);
        g_write<NB>(ra0, rb0, lds + 32768 + woff);
        __syncthreads();
        g_load<NB>(ra0, rb0, Ag, Bg, sa, sb, kt + 3 < nk ? kt + 3 : nk - 1);
        g_compute<MI, TRANS>(acc, lds + 32768 + aoff, lds + 32768 + boff, fq, sw);
        g_write<NB>(ra1, rb1, lds + woff);
        __syncthreads();
    }
    epi.template operator()<MI>(acc, m0, n0, rbase, wc, fr, fq, lds);
}


template <int BN>
struct GStream {
    static constexpr int MI = BN == 128 ? 4 : 2, NB = BN / 32;
    const bf16_t* A; const bf16_t* Bt; int lda, ldb, K; const float* ssq; unsigned char* lds;
    int tid, fr, fq, rbase, wc, woff, aoff, boff, sw, lrow, lc;
    u32x4 ra0[4], rb0[NB], ra1[4], rb1[NB];
    float pr[16];
    DEV void init(const bf16_t* A_, int lda_, const bf16_t* Bt_, int ldb_, int K_, const float* ssq_, unsigned char* lds_) {
        A = A_; Bt = Bt_; lda = lda_; ldb = ldb_; K = K_; ssq = ssq_; lds = lds_;
        tid = TIDX; const int lane = tid & 63, wid = tid >> 6; fr = lane & 15; fq = lane >> 4;
        const int wr = BN == 128 ? (wid >> 1) : wid; wc = BN == 128 ? (wid & 1) : 0;
        rbase = wr * (MI * 16);
        lrow = tid >> 3; lc = tid & 7;
        woff = lrow * 128 + ((lc ^ ((lrow >> 1) & 7)) << 4);
        sw = (fr >> 1) & 7;
        aoff = (rbase + fr) * 128; boff = 16384 + (wc * 64 + fr) * 128;
#pragma unroll
        for (int i = 0; i < 16; ++i) pr[i] = 0.f;
    }
    DEV void prefetch(int m0, int n0) {
        const u32x4* Ag = (const u32x4*)(A + (size_t)(m0 + lrow) * lda + lc * 8);
        const u32x4* Bg = (const u32x4*)(Bt + (size_t)(n0 + lrow) * ldb + lc * 8);
        const size_t sa = (size_t)4 * lda, sb = (size_t)4 * ldb;
        g_load<NB>(ra0, rb0, Ag, Bg, sa, sb, 0);
    }
    DEV void sched_pattern() {
        __builtin_amdgcn_sched_group_barrier(0x100, 2 * (MI + 4), 0);
#pragma unroll
        for (int i = 0; i < 4 + NB; ++i) {
            __builtin_amdgcn_sched_group_barrier(0x008, BN == 128 ? 4 : 2, 0);
            __builtin_amdgcn_sched_group_barrier(0x020, 1, 0);
            __builtin_amdgcn_sched_group_barrier(0x200, 1, 0);
        }
        if (BN == 64) __builtin_amdgcn_sched_group_barrier(0x008, 4, 0);
    }
    template <bool TRANS, class Epi>
    DEV void run_tile(int m0, int n0, int m0n, int n0n, const Epi& epi) {
        __syncthreads();
        g_write<NB>(ra0, rb0, lds + woff);
        if (ssq) {
            const float* q = ssq + m0 + (tid & 127);
#pragma unroll
            for (int i = 0; i < 16; ++i) pr[i] = q[(size_t)i * MROWS];
        }
        const u32x4* Ag = (const u32x4*)(A + (size_t)(m0 + lrow) * lda + lc * 8);
        const u32x4* Bg = (const u32x4*)(Bt + (size_t)(n0 + lrow) * ldb + lc * 8);
        const size_t sa = (size_t)4 * lda, sb = (size_t)4 * ldb;
        g_load<NB>(ra0, rb0, Ag, Bg, sa, sb, 1);
        __syncthreads();
        f32x4 acc[MI][4];
#pragma unroll
        for (int i = 0; i < MI; ++i)
#pragma unroll
            for (int j = 0; j < 4; ++j) acc[i][j] = (f32x4){0.f, 0.f, 0.f, 0.f};
        const int nk = K >> 6;
        for (int kt = 0; kt < nk; kt += 2) {
            __builtin_amdgcn_s_setprio(1);
            g_load<NB>(ra1, rb1, Ag, Bg, sa, sb, kt + 2 < nk ? kt + 2 : nk - 1);
            g_compute<MI, TRANS>(acc, lds + aoff, lds + boff, fq, sw);
            g_write<NB>(ra0, rb0, lds + 32768 + woff);
            sched_pattern();
            __builtin_amdgcn_s_setprio(0);
            __syncthreads();
            __builtin_amdgcn_s_setprio(1);
            g_load<NB>(ra0, rb0, Ag, Bg, sa, sb, kt + 3 < nk ? kt + 3 : nk - 1);
            g_compute<MI, TRANS>(acc, lds + 32768 + aoff, lds + 32768 + boff, fq, sw);
            g_write<NB>(ra1, rb1, lds + woff);
            sched_pattern();
            __builtin_amdgcn_s_setprio(0);
            __syncthreads();
        }
        if (ssq) {
            if (tid < 128) {
                float sacc = 0.f;
#pragma unroll
                for (int i = 0; i < 16; ++i) sacc += pr[i];
                ((float*)(lds + 65536))[tid] = rsqrtf(sacc * (1.0f / 1024.0f) + 1e-6f);
            }
            __syncthreads();
        }
        prefetch(m0n, n0n);
        epi.template operator()<MI>(acc, m0, n0, rbase, wc, fr, fq, lds);
    }
};

DEV void load_rstd(const float* ssq_site, int m0, unsigned char* lds) {
    __syncthreads();
    float* R = (float*)(lds + 65536);
    if (TIDX < 128) {
        float s = 0.f;
#pragma unroll
        for (int i = 0; i < 16; ++i) s += ssq_site[(size_t)i * MROWS + m0 + TIDX];
        R[TIDX] = rsqrtf(s * (1.0f / 1024.0f) + 1e-6f);
    }
    __syncthreads();
}

struct EpiIn {
    float* P; const float* SW; bf16_t* PF; float* out; int even; int jl;
    template <int MI> DEV void operator()(const f32x4 (&acc)[MI][4], int m0, int n0, int rbase, int wc, int fr, int fq, unsigned char* lds) const {
        const float* R = (const float*)(lds + 65536);
#pragma unroll
        for (int mi = 0; mi < MI; ++mi) {
            const int rl = rbase + mi * 16 + fr, row = m0 + rl;
            const float rs = R[rl];
            const float* sw = SW + vec_of_row(row) * 2048;
#pragma unroll
            for (int ni = 0; ni < 4; ++ni) {
                const int col = n0 + wc * 64 + ni * 16 + fq * 4;
                const f32x4 s4 = *(const f32x4*)(sw + col);
                f32x4 v = acc[mi][ni] * rs + s4;
                *(f32x4*)(P + (size_t)row * 2048 + col) = v;
                if (even) {
                    if (row < MCTX && col >= 512 && col < 768) {
                        const int b = row >> 8, lp = row & 255;
                        const size_t o = ((size_t)(b * 2 + jl) * 256 + lp) * 128;
                        if (col < 640) *(f32x4*)(out + OUT_K + o + (col - 512)) = v;
                        else *(f32x4*)(out + OUT_V + o + (col - 640)) = v;
                    }
                } else if (col < 512) {
                    uint2 w; w.x = pack2(v[0], v[1]); w.y = pack2(v[2], v[3]);
                    *(uint2*)(PF + (size_t)row * 512 + col) = w;
                }
            }
        }
    }
};
struct EpiInF {
    const float* SW; bf16_t* PF;
    template <int MI> DEV void operator()(const f32x4 (&acc)[MI][4], int m0, int n0, int rbase, int wc, int fr, int fq, unsigned char* lds) const {
        const float* R = (const float*)(lds + 65536);
#pragma unroll
        for (int mi = 0; mi < MI; ++mi) {
            const int rl = rbase + mi * 16 + fr, row = m0 + rl;
            const float rs = R[rl];
            const float* sw = SW + vec_of_row(row) * 2048;
#pragma unroll
            for (int ni = 0; ni < 4; ++ni) {
                const int col = n0 + wc * 64 + ni * 16 + fq * 4;
                const f32x4 v = acc[mi][ni] * rs + *(const f32x4*)(sw + col);
                uint2 w; w.x = pack2(v[0], v[1]); w.y = pack2(v[2], v[3]);
                *(uint2*)(PF + (size_t)row * 512 + col) = w;
            }
        }
    }
};
struct EpiInT {
    const float* SW; bf16_t* PT; int coff;
    template <int MI> DEV void operator()(const f32x4 (&acc)[MI][4], int m0, int n0, int rbase, int wc, int fr, int fq, unsigned char* lds) const {
        const float* R = (const float*)(lds + 65536);
#pragma unroll
        for (int mi = 0; mi < MI; ++mi) {
            const int rl = rbase + mi * 16 + fq * 4, row = m0 + rl;
            const f32x4 rs = *(const f32x4*)(R + rl);
            const float* sw = SW + vec_of_row(row) * 2048;
#pragma unroll
            for (int ni = 0; ni < 4; ++ni) {
                const int col = n0 + wc * 64 + ni * 16 + fr;
                const float sv = sw[col];
                const f32x4 v = acc[mi][ni] * rs + sv;
                uint2 w; w.x = pack2(v[0], v[1]); w.y = pack2(v[2], v[3]);
                *(uint2*)(PT + (size_t)(col + coff - 512) * MROWS + row) = w;
            }
        }
    }
};
struct EpiRes {
    float* X; bf16_t* XG; const float* gate;   const float* nw; const float* nscale;   float* ssq; int write_xg; float gscale;
    template <int MI> DEV void operator()(const f32x4 (&acc)[MI][4], int m0, int n0, int rbase, int wc, int fr, int fq, unsigned char*) const {
#pragma unroll
        for (int mi = 0; mi < MI; ++mi) {
            const int row = m0 + rbase + mi * 16 + fr;
            const int v = vec_of_row(row);
            float ss = 0.f;
#pragma unroll
            for (int ni = 0; ni < 4; ++ni) {
                const int col = n0 + wc * 64 + ni * 16 + fq * 4;
                const f32x4 g4 = *(const f32x4*)(gate + v * 6144 + col);
                f32x4 x = *(const f32x4*)(X + (size_t)row * 1024 + col);
                x = x + g4 * acc[mi][ni] * gscale;
                *(f32x4*)(X + (size_t)row * 1024 + col) = x;
                ss += x[0] * x[0] + x[1] * x[1] + x[2] * x[2] + x[3] * x[3];
                if (write_xg) {
                    const f32x4 w4 = *(const f32x4*)(nw + col);
                    const f32x4 s4 = *(const f32x4*)(nscale + v * 6144 + col);
                    const f32x4 y = x * w4 * (s4 + 1.0f);
                    uint2 w; w.x = pack2(y[0], y[1]); w.y = pack2(y[2], y[3]);
                    *(uint2*)(XG + (size_t)row * 1024 + col) = w;
                }
            }
            ss += __shfl_xor(ss, 16); ss += __shfl_xor(ss, 32);
            if (fq == 0) ssq[(size_t)((n0 + wc * 64) >> 6) * MROWS + row] = ss;
        }
    }
};
struct EpiMlp1 {
    bf16_t* H; const float* SW;
    template <int MI> DEV void operator()(const f32x4 (&acc)[MI][4], int m0, int n0, int rbase, int wc, int fr, int fq, unsigned char* lds) const {
        const float* R = (const float*)(lds + 65536);
#pragma unroll
        for (int mi = 0; mi < MI; ++mi) {
            const int rl = rbase + mi * 16 + fr, row = m0 + rl;
            const float rs = R[rl];
            const float* sw = SW + vec_of_row(row) * 4096;
#pragma unroll
            for (int ni = 0; ni < 4; ++ni) {
                const int col = n0 + wc * 64 + ni * 16 + fq * 4;
                const f32x4 s4 = *(const f32x4*)(sw + col);
                f32x4 v = acc[mi][ni] * rs + s4;
#pragma unroll
                for (int e = 0; e < 4; ++e) { float r = fmaxf(v[e], 0.f); v[e] = r * r; }
                uint2 w; w.x = pack2(v[0], v[1]); w.y = pack2(v[2], v[3]);
                *(uint2*)(H + (size_t)row * 4096 + col) = w;
            }
        }
    }
};
struct EpiF1 {
    bf16_t* FT; int L; int g;
    template <int MI> DEV void operator()(const f32x4 (&acc)[MI][4], int m0, int n0, int rbase, int wc, int fr, int fq, unsigned char*) const {
#pragma unroll
        for (int mi = 0; mi < MI; ++mi) {
            const int n = m0 + rbase + mi * 16 + fr;
            bf16_t* dst = FT + (size_t)(g * 128 + (n & 127)) * (2 * L) + (n >> 7) * L;
#pragma unroll
            for (int ni = 0; ni < 4; ++ni) {
                const int col = n0 + wc * 64 + ni * 16 + fq * 4;
                uint2 w; w.x = pack2(acc[mi][ni][0], acc[mi][ni][1]); w.y = pack2(acc[mi][ni][2], acc[mi][ni][3]);
                *(uint2*)(dst + col) = w;
            }
        }
    }
};
struct EpiF2 {
    bf16_t* MIX; int rowbase;
    template <int MI> DEV void operator()(const f32x4 (&acc)[MI][4], int m0, int n0, int rbase, int wc, int fr, int fq, unsigned char*) const {
#pragma unroll
        for (int mi = 0; mi < MI; ++mi) {
            const int row = rowbase + m0 + rbase + mi * 16 + fr;
#pragma unroll
            for (int ni = 0; ni < 4; ++ni) {
                const int col = n0 + wc * 64 + ni * 16 + fq * 4;
                uint2 w; w.x = pack2(acc[mi][ni][0], acc[mi][ni][1]); w.y = pack2(acc[mi][ni][2], acc[mi][ni][3]);
                *(uint2*)(MIX + (size_t)row * 1024 + col) = w;
            }
        }
    }
};

DEV void tile_decode(int t, int NT, int& pm, int& pn) { const int g = t / (4 * NT), r = t % (4 * NT); pn = r >> 2; pm = g * 4 + (r & 3); }

struct TrDesc { const float* src; bf16_t* dst; int K, N; };
DEV TrDesc tr_decode(const Params& p, int t) {
    unsigned char* ws = p.ws;
    int l = 0;
    for (;;) { const int cnt = (l & 1) ? 2816 : 2752; if (t < cnt) break; t -= cnt; ++l; }
    const int j = l >> 1, odd = l & 1;
    const int nin = odd ? 2048 : 1792, tin = 16 * (nin / 64);
    const float* W; bf16_t* Wt; int K, N, kt, nt;
    if (t < tin) { W = odd ? p.in[24] + (size_t)j * 1024 * 2048 : p.in[14] + (size_t)j * 1024 * 1792; Wt = (bf16_t*)(ws + OFF_WTIN) + (size_t)l * 2048 * 1024; K = 1024; N = nin; kt = t % 16; nt = t / 16; }
    else if (t < tin + 256) { t -= tin; W = (odd ? p.in[25] : p.in[15]) + (size_t)j * 1024 * 1024; Wt = (bf16_t*)(ws + OFF_WTOUT) + (size_t)l * 1024 * 1024; K = 1024; N = 1024; kt = t % 16; nt = t / 16; }
    else if (t < tin + 256 + 1024) { t -= tin + 256; W = p.in[12] + (size_t)l * 1024 * 4096; Wt = (bf16_t*)(ws + OFF_WT1) + (size_t)l * 4096 * 1024; K = 1024; N = 4096; kt = t % 16; nt = t / 16; }
    else { t -= tin + 256 + 1024; W = p.in[13] + (size_t)l * 4096 * 1024; Wt = (bf16_t*)(ws + OFF_WT2) + (size_t)l * 1024 * 4096; K = 4096; N = 1024; kt = t % 64; nt = t / 64; }
    TrDesc d; d.src = W + (size_t)kt * 64 * N + nt * 64; d.dst = Wt + (size_t)nt * 64 * K + kt * 64; d.K = K; d.N = N;
    return d;
}
DEV void tr_load(const TrDesc& d, f32x4 (&r)[4], int tid) {
    const int r0 = tid >> 4, c4 = (tid & 15) * 4;
#pragma unroll
    for (int i = 0; i < 4; ++i) r[i] = __builtin_nontemporal_load((const f32x4*)(d.src + (size_t)(r0 + 16 * i) * d.N + c4));
}
DEV void tr_store(const TrDesc& d, const f32x4 (&r)[4], float* lds, int tid) {
    const int r0 = tid >> 4, c4 = (tid & 15) * 4;
    __syncthreads();
#pragma unroll
    for (int i = 0; i < 4; ++i)
#pragma unroll
        for (int e = 0; e < 4; ++e) lds[(r0 + 16 * i) * 65 + c4 + e] = r[i][e];
    __syncthreads();
    const int n = tid >> 2, kc = (tid & 3) * 16;
    unsigned w[8];
#pragma unroll
    for (int e = 0; e < 8; ++e) w[e] = pack2(lds[(kc + 2 * e) * 65 + n], lds[(kc + 2 * e + 1) * 65 + n]);
    uint4* dst = (uint4*)(d.dst + (size_t)n * d.K + kc);
    dst[0] = make_uint4(w[0], w[1], w[2], w[3]);
    dst[1] = make_uint4(w[4], w[5], w[6], w[7]);
}

DEV void gemv3_unit(const float* vecs  , const float* __restrict__ W, int N, int col0, const float* bias, float* out, int ostride, float* red  ) {
    const int w = TIDX >> 6, lane = TIDX & 63;
    const float* Wp = W + col0 + lane;
    float a0 = 0.f, a1 = 0.f, a2 = 0.f;
#pragma unroll 32
    for (int k = w * 256; k < w * 256 + 256; ++k) {
        const float wv = __builtin_nontemporal_load(Wp + (size_t)k * N);
        a0 += vecs[k] * wv; a1 += vecs[1024 + k] * wv; a2 += vecs[2048 + k] * wv;
    }
    red[(w * 3 + 0) * 64 + lane] = a0; red[(w * 3 + 1) * 64 + lane] = a1; red[(w * 3 + 2) * 64 + lane] = a2;
    __syncthreads();
    if (TIDX < 192) {
        const int v = TIDX >> 6;
        float s = red[(0 * 3 + v) * 64 + lane] + red[(1 * 3 + v) * 64 + lane] + red[(2 * 3 + v) * 64 + lane] + red[(3 * 3 + v) * 64 + lane];
        if (bias) s += bias[col0 + lane];
        out[(size_t)v * ostride + col0 + lane] = s;
    }
    __syncthreads();
}

DEV void phase_prepA(const Params& p, unsigned char* lds, int vb, int G) {
    unsigned char* ws = p.ws;
    float* fl = (float*)lds;
    const int NU = 977;
    for (int u = vb; u < NU; u += G) {
        if (u < 384) {
            const int l = u / 96, ct = u % 96;
            __syncthreads();
            for (int i = TIDX; i < 3072; i += 256) {
                const int v = i >> 10, k = i & 1023;
                const float cv = (v == 0) ? p.in[6][k] : p.in[2][(v - 1) * 1024 + k];
                fl[i] = cv / (1.0f + expf(-cv));
            }
            __syncthreads();
            gemv3_unit(fl, p.in[7] + (size_t)l * 1024 * 6144, 6144, ct * 64, p.in[8] + l * 6144, (float*)(ws + OFF_MOD) + l * 3 * 6144, 6144, fl + 3072);
        } else if (u < 424) {
            const int uu = u - 384, j = uu / 20, tb = uu % 20;
            const float* w1 = p.in[28] + j * 33 * 64; const float* b1 = p.in[29] + j * 64;
            const float* w2 = p.in[30] + j * 64 * 64; const float* b2 = p.in[31] + j * 64;
            const float* fr_ = p.in[33] + j * 128;
            float* HID = (float*)(ws + OFF_HID) + (size_t)j * 1280 * 64;
            float* zb = fl; float* h1 = fl + 256;
            const int o = TIDX & 63, tg = TIDX >> 6;
            float w1c[33], w2c[64];
#pragma unroll
            for (int e = 0; e < 33; ++e) w1c[e] = w1[e * 64 + o];
#pragma unroll
            for (int e = 0; e < 64; ++e) w2c[e] = w2[e * 64 + o];
            const float b1o = b1[o], b2o = b2[o], f0o = fr_[o], f1o = fr_[64 + o];
#pragma unroll 1
            for (int it = 0; it < 16; ++it) {
                const int gp = tb * 64 + it * 4 + tg;
                const int L = gp < 256 ? 256 : 1024, t = gp < 256 ? gp : gp - 256;
                __syncthreads();
                if (o < 33) {
                    float z;
                    if (o == 0) z = (float)t / (float)L;
                    else {
                        const int bi = (o - 1) & 15;
                        const float band = 1e-4f + (float)bi * ((15.0f - 1e-4f) / 15.0f);
                        const float w = (6.283185307179586f / (float)L) * (float)t;
                        const float a = w * band;
                        z = (o <= 16) ? cosf(a) : -sinf(a);
                    }
                    zb[tg * 40 + o] = z;
                }
                __syncthreads();
                float s = b1o;
#pragma unroll
                for (int e = 0; e < 33; ++e) s += zb[tg * 40 + e] * w1c[e];
                h1[tg * 64 + o] = sinf(f0o * s);
                __syncthreads();
                float s2 = b2o;
#pragma unroll
                for (int e = 0; e < 64; ++e) s2 += h1[tg * 64 + e] * w2c[e];
                HID[(size_t)gp * 64 + o] = sinf(f1o * s2);
            }
        } else if (u < 977) {
            const int e0 = (u - 424) * 4096;
            for (int i = TIDX; i < 4096; i += 256) {
                const int e = e0 + i;
                if (e < 32768) {
                    const int n = e >> 7, k = e & 127;
                    const float a = 6.283185307179586f * (float)(((n & 127) * k) & 127) / 128.0f;
                    ((bf16_t*)(ws + OFF_CS128))[e] = f2bf(n < 128 ? cosf(a) : sinf(a));
                } else if (e < 163840) {
                    const int q = e - 32768, lp = q >> 9, k2 = q & 511, l = k2 & 255;
                    const float a = 6.283185307179586f * (float)((lp * l) & 255) / 256.0f;
                    const float sc = 0.005524271728019903f;
                    ((bf16_t*)(ws + OFF_CSL256))[q] = f2bf(k2 < 256 ? sc * cosf(a) : -sc * sinf(a));
                } else if (e < 2260992) {
                    const int q = e - 163840, lp = q >> 11, k2 = q & 2047, l = k2 & 1023;
                    const float a = 6.283185307179586f * (float)((lp * l) & 1023) / 1024.0f;
                    const float sc = 0.0027621358640099515f;
                    ((bf16_t*)(ws + OFF_CSL1024))[q] = f2bf(k2 < 1024 ? sc * cosf(a) : -sc * sinf(a));
                } else if (e < 2262016) {
                    const int q = e - 2260992, pos = q >> 4, i2 = q & 15;
                    const float inv = powf(10000.0f, -(float)i2 / 16.0f);
                    const float a = (float)pos * inv;
                    ((float2*)(ws + OFF_ROPE))[q] = make_float2(cosf(a), sinf(a));
                }
            }
        }
    }
    {
        const int tid = TIDX;
        const int NTT = 11136;
        int t = vb;
        if (t < NTT) {
            TrDesc d = tr_decode(p, t);
            f32x4 r[4];
            tr_load(d, r, tid);
            while (t < NTT) {
                const int tn = t + G;
                const TrDesc dn = tr_decode(p, tn < NTT ? tn : t);
                f32x4 rn[4];
                tr_load(dn, rn, tid);
                tr_store(d, r, fl, tid);
                d = dn;
#pragma unroll
                for (int i = 0; i < 4; ++i) r[i] = rn[i];
                t = tn;
            }
        }
    }
}

DEV void sw_unit(const Params& p, int u, unsigned char* lds) {
    unsigned char* ws = p.ws;
    const float* MOD = (const float*)(ws + OFF_MOD);
    int t = u, l = 0;
    for (;;) { const int cnt = (l & 1) ? 96 : 92; if (t < cnt) break; t -= cnt; ++l; }
    const int odd = l & 1, nin = odd ? 2048 : 1792, tin = nin / 64;
    const int which = t < tin ? 0 : 1;
    const int tid = TIDX, lane = tid & 63, w = tid >> 6;
    const bf16_t* WT = which == 0 ? (const bf16_t*)(ws + OFF_WTIN) + (size_t)l * 2048 * 1024 : (const bf16_t*)(ws + OFF_WT1) + (size_t)l * 4096 * 1024;
    float* out = which == 0 ? (float*)(ws + OFF_SWIN) + l * 3 * 2048 : (float*)(ws + OFF_SW1) + l * 3 * 4096;
    const int ostride = which == 0 ? 2048 : 4096;
    const int col0 = (which == 0 ? t : t - tin) * 64 + w * 16;
    f32x4 sv[3][4];
#pragma unroll
    for (int v = 0; v < 3; ++v)
#pragma unroll
        for (int q = 0; q < 4; ++q) sv[v][q] = *(const f32x4*)(MOD + (l * 3 + v) * 6144 + (which ? 3 : 0) * 1024 + lane * 16 + q * 4);
#pragma unroll 4
    for (int i = 0; i < 16; ++i) {
        const u32x4* rp = (const u32x4*)(WT + (size_t)(col0 + i) * 1024 + lane * 16);
        const u32x4 r0 = rp[0], r1 = rp[1];
        const unsigned wv[8] = {r0.x, r0.y, r0.z, r0.w, r1.x, r1.y, r1.z, r1.w};
        float a[3] = {0.f, 0.f, 0.f};
#pragma unroll
        for (int e = 0; e < 8; ++e) {
            const float lo = __uint_as_float(wv[e] << 16), hi = __uint_as_float(wv[e] & 0xffff0000u);
#pragma unroll
            for (int v = 0; v < 3; ++v) a[v] += sv[v][e >> 1][(e & 1) * 2] * lo + sv[v][e >> 1][(e & 1) * 2 + 1] * hi;
        }
#pragma unroll
        for (int v = 0; v < 3; ++v) {
#pragma unroll
            for (int o = 32; o >= 1; o >>= 1) a[v] += __shfl_xor(a[v], o);
        }
        if (lane == 0) { out[col0 + i] = a[0]; out[ostride + col0 + i] = a[1]; out[2 * ostride + col0 + i] = a[2]; }
    }
}
DEV void filter_unit(const Params& p, int uu0, unsigned char* lds) {
    unsigned char* ws = p.ws;
    float* fl = (float*)lds;
    const int tid0 = TIDX;
    const int u = uu0 + 376;
    {
            const int uu = u - 376;
            const int cgp = uu & 31, n = (uu >> 5) & 1, ls = (uu >> 6) & 1, j = uu >> 7;
            const int L = ls ? 1024 : 256;
            const int colid = tid0 & 31, tq = tid0 >> 5;
            const int dir = colid >> 4, c = cgp * 16 + (colid & 15);
            const int col = dir * 1024 + n * 512 + c;
            const float* w3 = p.in[32] + (size_t)j * 64 * 2048 + col;
            const float dec = expf(p.in[34][j * 2048 + col]);
            const float* HID = (const float*)(ws + OFF_HID) + ((size_t)j * 1280 + (ls ? 256 : 0)) * 64;
            float* TF = (float*)(ws + OFF_TF + (size_t)j * 10 * MiB + (ls ? 2 * MiB : 0)) + ((size_t)n * 512 + c) * (2 * L);
            float wv[64];
#pragma unroll
            for (int e = 0; e < 64; ++e) wv[e] = w3[(size_t)e * 2048];
            float ss = 0.f;
            const int tper = L >> 3;
#pragma unroll 1
            for (int c0 = 0; c0 < tper; c0 += 16) {
                __syncthreads();
#pragma unroll
                for (int k = 0; k < 8; ++k) {
                    const int e = tid0 + 256 * k, r = e >> 4, c4 = e & 15;
                    *(f32x4*)(fl + r * 64 + c4 * 4) = *(const f32x4*)(HID + (size_t)((r >> 4) * tper + c0 + (r & 15)) * 64 + c4 * 4);
                }
                __syncthreads();
#pragma unroll 1
                for (int i = 0; i < 16; ++i) {
                    const int t = tq * tper + c0 + i;
                    const float* h = fl + (tq * 16 + i) * 64;
                    float sacc = 0.f;
#pragma unroll
                    for (int e = 0; e < 64; e += 4) { const f32x4 hv = *(const f32x4*)(h + e); sacc += hv[0] * wv[e] + hv[1] * wv[e + 1] + hv[2] * wv[e + 2] + hv[3] * wv[e + 3]; }
                    sacc *= expf(-((float)t / (float)L) * dec);
                    ss += sacc * sacc;
                    TF[dir ? (L + t) : (L - 1 - t)] = sacc;
                }
            }
            __syncthreads();
            fl[tq * 32 + colid] = ss;
            __syncthreads();
            const int cl = colid & 15;
            float tot = 0.f;
#pragma unroll
            for (int q = 0; q < 8; ++q) tot += fl[q * 32 + cl] + fl[q * 32 + 16 + cl];
            if (tid0 < 16) ((float*)(ws + OFF_HID + 655360))[((j * 2 + ls) * 2 + n) * 512 + cgp * 16 + tid0] = rsqrtf(tot + 1e-6f);
            __syncthreads();
    }
}
DEV void phase_prepB(const Params& p, unsigned char* lds, int vb, int G) {
    unsigned char* ws = p.ws;
    const float* MOD = (const float*)(ws + OFF_MOD);
    for (int u0 = vb; u0 < 668; u0 += G) {
        if (u0 < 28) sw_unit(p, u0, lds);
        else {
            const int u = u0 - 28 + 632;
            const int r0 = (u - 632) * 16 + (TIDX >> 6) * 4, lane = TIDX & 63;
            float* X = (float*)(ws + OFF_X); bf16_t* XG = (bf16_t*)(ws + OFF_XG); float* SSQ = (float*)(ws + OFF_SSQ);
            for (int rr = 0; rr < 4; ++rr) {
                const int row = r0 + rr, v = vec_of_row(row);
                const float* src = row < MCTX ? p.in[0] + (size_t)row * 1024 : p.in[1] + (size_t)(row - MCTX) * 1024;
                float ss = 0.f;
#pragma unroll
                for (int i = 0; i < 4; ++i) {
                    const int col = lane * 4 + i * 256;
                    const f32x4 x = *(const f32x4*)(src + col);
                    ss += x[0] * x[0] + x[1] * x[1] + x[2] * x[2] + x[3] * x[3];
                    *(f32x4*)(X + (size_t)row * 1024 + col) = x;
                    const f32x4 w4 = *(const f32x4*)(p.in[9] + col);
                    const f32x4 s4 = *(const f32x4*)(MOD + v * 6144 + 1024 + col);
                    const f32x4 y = x * w4 * (s4 + 1.0f);
                    uint2 w; w.x = pack2(y[0], y[1]); w.y = pack2(y[2], y[3]);
                    *(uint2*)(XG + (size_t)row * 1024 + col) = w;
                }
#pragma unroll
                for (int o = 32; o >= 1; o >>= 1) ss += __shfl_xor(ss, o);
                if (lane < 16) SSQ[(size_t)lane * MROWS + row] = lane == 0 ? ss : 0.f;
            }
        }
    }
}

template <bool TRANS, class Epi>
DEV void gemm_in_loop(const bf16_t* A, const bf16_t* Bt, const float* ssq, unsigned char* lds, int vb, int rev, int ntile, int NT, int G, const Epi& epi) {
    const int nfull = ntile / G, R = ntile - nfull * G, slots = G >> 3;
    const int q = rev ? slots - 1 - (int)(blockIdx.x >> 3) : (int)(blockIdx.x >> 3);
    const int extra = ((G & 7) == 0 && (R & 7) == 0) ? (q < (R >> 3) ? nfull * G + (int)(blockIdx.x & 7) * (R >> 3) + q : -1) : (vb < R ? nfull * G + vb : -1);
    const int cnt = nfull + (extra >= 0 ? 1 : 0);
    if (cnt == 0) return;
    GStream<128> gs; gs.init(A, 1024, Bt, 1024, 1024, ssq, lds);
    int i = 0;
    int t = nfull > 0 ? vb : extra;
    int pm, pn; tile_decode(t, NT, pm, pn);
    gs.prefetch(pm * 128, pn * 128);
    for (;;) {
        const int inx = i + 1;
        const int tn = inx < nfull ? vb + inx * G : (inx < cnt ? extra : t);
        int pmn, pnn; tile_decode(tn, NT, pmn, pnn);
        gs.template run_tile<TRANS>(pm * 128, pn * 128, pmn * 128, pnn * 128, epi);
        if (inx >= cnt) break;
        i = inx; t = tn; pm = pmn; pn = pnn;
    }
}
DEV void phase_gemm_in(const Params& p, int l, unsigned char* lds, int vb, int G) {
    unsigned char* ws = p.ws;
    const int odd = l & 1;
    const float* ssq = (const float*)(ws + OFF_SSQ) + (size_t)(2 * l) * 16 * MROWS;
    const bf16_t* A = (const bf16_t*)(ws + OFF_XG); const bf16_t* Bt = (const bf16_t*)(ws + OFF_WTIN) + (size_t)l * 2048 * 1024;
    const float* SW = (const float*)(ws + OFF_SWIN) + l * 3 * 2048;
    if (!odd) {
        EpiIn epi; epi.P = (float*)(ws + OFF_P); epi.SW = SW; epi.PF = (bf16_t*)(ws + OFF_PF); epi.out = p.out; epi.even = 1; epi.jl = l >> 1;
        if (G == 512) {
            gemm_in_loop<false>(A, Bt, ssq, lds, vb, 0, 1024, 14, G, epi);
            const int q = (int)(blockIdx.x >> 3);
            if (q < 24) {
                const int h = (int)(blockIdx.x & 7) * 24 + q;
                int pm, pn; tile_decode(1024 + (h >> 1), 14, pm, pn);
                GStream<64> g2; g2.init(A, 1024, Bt, 1024, 1024, ssq, lds);
                g2.prefetch(pm * 128, pn * 128 + (h & 1) * 64);
                g2.run_tile<false>(pm * 128, pn * 128 + (h & 1) * 64, pm * 128, pn * 128 + (h & 1) * 64, epi);
            }
        } else gemm_in_loop<false>(A, Bt, ssq, lds, vb, 0, 80 * 14, 14, G, epi);
    } else {
        EpiInF ef; ef.SW = SW; ef.PF = (bf16_t*)(ws + OFF_PF);
        EpiInT et; et.SW = SW; et.PT = (bf16_t*)(ws + OFF_HU); et.coff = 0;
        gemm_in_loop<false>(A, Bt, ssq, lds, vb, 0, 320, 4, G, ef);
        EpiInT et2 = et; et2.SW = SW + 512; et2.PT = et.PT;
        et2.coff = 512;
        gemm_in_loop<true>(A, Bt + (size_t)512 * 1024, ssq, lds, vb, 1, 960, 12, G, et2);
    }
}
DEV void phase_gemm_res(const Params& p, int l, int which  , unsigned char* lds, int vb, int G, float gscale = 1.0f) {
    unsigned char* ws = p.ws;
    const float* MOD = (const float*)(ws + OFF_MOD);
    EpiRes epi; epi.X = (float*)(ws + OFF_X); epi.XG = (bf16_t*)(ws + OFF_XG); epi.gscale = gscale;
    const bf16_t* A; const bf16_t* Bt; int K;
    if (which == 0) {
        epi.gate = MOD + (size_t)l * 3 * 6144 + 2 * 1024; epi.nw = p.in[10] + l * 1024; epi.nscale = MOD + (size_t)l * 3 * 6144 + 4 * 1024;
        epi.ssq = (float*)(ws + OFF_SSQ) + (size_t)(2 * l + 1) * 16 * MROWS; epi.write_xg = 1;
        A = (const bf16_t*)(ws + OFF_MIX); Bt = (const bf16_t*)(ws + OFF_WTOUT) + (size_t)l * 1024 * 1024; K = 1024;
    } else {
        const int ln = l < 3 ? l + 1 : 3;
        epi.gate = MOD + (size_t)l * 3 * 6144 + 5 * 1024; epi.nw = p.in[9] + ln * 1024; epi.nscale = MOD + (size_t)ln * 3 * 6144 + 1 * 1024;
        epi.ssq = (float*)(ws + OFF_SSQ) + (size_t)(2 * l + 2) * 16 * MROWS; epi.write_xg = l < 3;
        A = (const bf16_t*)(ws + OFF_P); Bt = (const bf16_t*)(ws + OFF_WT2) + (size_t)l * 1024 * 4096; K = 4096;
    }
    int t = vb;
    if (t >= 640) return;
    int pm, pn; tile_decode(t, 8, pm, pn);
    {
        GStream<128> gs; gs.init(A, K, Bt, K, K, nullptr, lds);
        gs.prefetch(pm * 128, pn * 128);
        gs.run_tile<false>(pm * 128, pn * 128, pm * 128, pn * 128, epi);
        if (G != 512) { for (int t3 = vb + G; t3 < 640; t3 += G) { tile_decode(t3, 8, pm, pn); gs.prefetch(pm * 128, pn * 128); gs.run_tile<false>(pm * 128, pn * 128, pm * 128, pn * 128, epi); } return; }
    }
    if ((int)(blockIdx.x >> 3) < 32) {
        const int h = (int)(blockIdx.x & 7) * 32 + (int)(blockIdx.x >> 3);
        tile_decode(512 + (h >> 1), 8, pm, pn);
        GStream<64> g2; g2.init(A, K, Bt, K, K, nullptr, lds);
        g2.prefetch(pm * 128, pn * 128 + (h & 1) * 64);
        g2.run_tile<false>(pm * 128, pn * 128 + (h & 1) * 64, pm * 128, pn * 128 + (h & 1) * 64, epi);
    }
}
DEV void phase_gemm_mlp1(const Params& p, int l, unsigned char* lds, int vb, int G) {
    unsigned char* ws = p.ws;
    EpiMlp1 epi; epi.H = (bf16_t*)(ws + OFF_P); epi.SW = (const float*)(ws + OFF_SW1) + l * 3 * 4096;
    const float* ssq = (const float*)(ws + OFF_SSQ) + (size_t)(2 * l + 1) * 16 * MROWS;
    const bf16_t* A = (const bf16_t*)(ws + OFF_XG); const bf16_t* Bt = (const bf16_t*)(ws + OFF_WT1) + (size_t)l * 4096 * 1024;
    int t = vb;
    if (t >= 2560) return;
    GStream<128> gs; gs.init(A, 1024, Bt, 1024, 1024, ssq, lds);
    int pm, pn; tile_decode(t, 32, pm, pn);
    gs.prefetch(pm * 128, pn * 128);
    for (;;) {
        const int tn = t + G, tq = tn < 2560 ? tn : t;
        int pmn, pnn; tile_decode(tq, 32, pmn, pnn);
        gs.run_tile<false>(pm * 128, pn * 128, pmn * 128, pnn * 128, epi);
        if (tn >= 2560) break;
        t = tn; pm = pmn; pn = pnn;
    }
}

DEV float gelu_tanh(float x) { const float u = 0.7978845608028654f * (x + 0.044715f * x * x * x); return 0.5f * x * (1.0f + tanhf(u)); }

DEV void attn_unit(const Params& p, int jl, int latent, int b, int kv, int qt, unsigned char* lds) {
    unsigned char* ws = p.ws;
    const float* P = (const float*)(ws + OFF_P);
    const float2* ROPE = (const float2*)(ws + OFF_ROPE);
    bf16_t* MIX = (bf16_t*)(ws + OFF_MIX);
    const int tid = TIDX, lane = tid & 63, g = tid >> 6, fr = lane & 15, fq = lane >> 4;
    const int h = kv * 4 + g;
    const int rowbase = latent ? MCTX + b * 1024 : b * 256;
    const int q0 = qt * 32;
    bf16x8 qf[2][2];
#pragma unroll
    for (int qs = 0; qs < 2; ++qs) {
        const int lq = q0 + qs * 16 + fr;
        const float* qp = P + (size_t)(rowbase + lq) * 2048 + h * 64;
#pragma unroll
        for (int dk = 0; dk < 2; ++dk) {
            const int d0 = dk * 32 + fq * 8;
            f32x4 x0 = *(const f32x4*)(qp + d0), x1 = *(const f32x4*)(qp + d0 + 4);
            float xv[8] = {x0[0], x0[1], x0[2], x0[3], x1[0], x1[1], x1[2], x1[3]};
            if (latent) {
                const int dp = d0 ^ 16;
                f32x4 y0 = *(const f32x4*)(qp + dp), y1 = *(const f32x4*)(qp + dp + 4);
                float yv[8] = {y0[0], y0[1], y0[2], y0[3], y1[0], y1[1], y1[2], y1[3]};
                const int pos = dk == 0 ? (lq >> 6) : (lq & 63);
                const float sgn = (fq & 2) ? 1.0f : -1.0f;
#pragma unroll
                for (int e = 0; e < 8; ++e) { const float2 cs = ROPE[pos * 16 + (fq & 1) * 8 + e]; xv[e] = xv[e] * cs.x + sgn * yv[e] * cs.y; }
            }
#pragma unroll
            for (int e = 0; e < 8; ++e) qf[qs][dk][e] = (short)f2bf(xv[e] * 0.125f);
        }
    }
    float m[2], lsum[2];
    f32x4 o[2][4];
#pragma unroll
    for (int qs = 0; qs < 2; ++qs) {
        m[qs] = p.in[16][jl * 8 + h]; lsum[qs] = fq == 0 ? 1.0f : 0.0f;
#pragma unroll
        for (int i = 0; i < 4; ++i) o[qs][i] = (f32x4){0.f, 0.f, 0.f, 0.f};
    }
    int lo = 0, nwin = 8;
    if (latent) { lo = q0 - 128; if (lo < 0) lo = 0; lo &= ~31; int hi = q0 + 32 + 128 + 31; hi &= ~31; if (hi > 1024) hi = 1024; nwin = (hi - lo) >> 5; }
    const int ntiles = latent ? nwin + 8 : 8;
    unsigned char* KL = lds; unsigned char* VL = lds + 4096;
    const int skey = tid >> 3, sub = tid & 7;
    const int a = sub >> 2, i4 = (sub & 3) * 4;
    f32x4 x1, x2, v0, v1;
    {
        const int key0 = lo + skey;
        const float* r = P + (size_t)(rowbase + key0) * 2048; const float* ksrc = r + 512 + kv * 64; const float* vsrc = r + 640 + kv * 64;
        x1 = *(const f32x4*)(ksrc + a * 32 + i4); x2 = *(const f32x4*)(ksrc + a * 32 + 16 + i4);
        v0 = *(const f32x4*)(vsrc + sub * 8); v1 = *(const f32x4*)(vsrc + sub * 8 + 4);
    }
    for (int kt = 0; kt < ntiles; ++kt) {
        const bool win = kt < nwin;
        const int k0 = win ? lo + kt * 32 : (kt - nwin) * 32;
        const int key = k0 + skey;
        __syncthreads();
        {
            f32x4 o1 = x1, o2 = x2;
            if (latent && win) {
                const int pos = a == 0 ? (key >> 6) : (key & 63);
#pragma unroll
                for (int e = 0; e < 4; ++e) { const float2 cs = ROPE[pos * 16 + i4 + e]; o1[e] = x1[e] * cs.x - x2[e] * cs.y; o2[e] = x2[e] * cs.x + x1[e] * cs.y; }
            }
            const int swz = (skey >> 1) & 7;
            const int d1 = a * 32 + i4, d2 = d1 + 16;
            uint2 w1; w1.x = pack2(o1[0], o1[1]); w1.y = pack2(o1[2], o1[3]);
            uint2 w2; w2.x = pack2(o2[0], o2[1]); w2.y = pack2(o2[2], o2[3]);
            *(uint2*)(KL + skey * 128 + (((d1 >> 3) ^ swz) << 4) + (d1 & 7) * 2) = w1;
            *(uint2*)(KL + skey * 128 + (((d2 >> 3) ^ swz) << 4) + (d2 & 7) * 2) = w2;
#pragma unroll
            for (int e = 0; e < 4; ++e) {
                *(bf16_t*)(VL + (sub * 8 + e) * 80 + skey * 2) = f2bf(v0[e]);
                *(bf16_t*)(VL + (sub * 8 + 4 + e) * 80 + skey * 2) = f2bf(v1[e]);
            }
        }
        __syncthreads();
        {
            const int ktn = kt + 1 < ntiles ? kt + 1 : kt;
            const bool winn = ktn < nwin; const int keyn = (winn ? lo + ktn * 32 : (ktn - nwin) * 32) + skey;
            const float* ksrc; const float* vsrc;
            if (winn) { const float* r = P + (size_t)(rowbase + keyn) * 2048; ksrc = r + 512 + kv * 64; vsrc = r + 640 + kv * 64; }
            else { const size_t o2 = ((size_t)(b * 2 + jl) * 256 + keyn) * 128 + kv * 64; ksrc = p.in[3] + o2; vsrc = p.in[4] + o2; }
            x1 = *(const f32x4*)(ksrc + a * 32 + i4); x2 = *(const f32x4*)(ksrc + a * 32 + 16 + i4);
            v0 = *(const f32x4*)(vsrc + sub * 8); v1 = *(const f32x4*)(vsrc + sub * 8 + 4);
        }
        bf16x8 kf[2][2];
#pragma unroll
        for (int t = 0; t < 2; ++t) {
            const int kr = t * 16 + fr, swz = (kr >> 1) & 7;
#pragma unroll
            for (int dk = 0; dk < 2; ++dk) kf[t][dk] = *(const bf16x8*)(KL + kr * 128 + (((dk * 4 + fq) ^ swz) << 4));
        }
        bf16x8 vf[4];
#pragma unroll
        for (int dt = 0; dt < 4; ++dt) {
            const unsigned char* vp = VL + (dt * 16 + fr) * 80 + fq * 8;
            const s16x4 va = *(const s16x4*)vp, vb2 = *(const s16x4*)(vp + 32);
            vf[dt][0] = va[0]; vf[dt][1] = va[1]; vf[dt][2] = va[2]; vf[dt][3] = va[3]; vf[dt][4] = vb2[0]; vf[dt][5] = vb2[1]; vf[dt][6] = vb2[2]; vf[dt][7] = vb2[3];
        }
#pragma unroll
        for (int qs = 0; qs < 2; ++qs) {
            const int lq = q0 + qs * 16 + fr;
            f32x4 s[2];
#pragma unroll
            for (int t = 0; t < 2; ++t) {
                s[t] = (f32x4){0.f, 0.f, 0.f, 0.f};
#pragma unroll
                for (int dk = 0; dk < 2; ++dk) s[t] = __builtin_amdgcn_mfma_f32_16x16x32_bf16(kf[t][dk], qf[qs][dk], s[t], 0, 0, 0);
            }
            if (latent && win) {
#pragma unroll
                for (int t = 0; t < 2; ++t)
#pragma unroll
                    for (int jj = 0; jj < 4; ++jj) { const int kk = k0 + t * 16 + fq * 4 + jj; int d = lq - kk; d = d < 0 ? -d : d; if (d > 128) s[t][jj] = -1e30f; }
            }
            float mx = fmaxf(fmaxf(fmaxf(s[0][0], s[0][1]), fmaxf(s[0][2], s[0][3])), fmaxf(fmaxf(s[1][0], s[1][1]), fmaxf(s[1][2], s[1][3])));
            mx = fmaxf(mx, __shfl_xor(mx, 16)); mx = fmaxf(mx, __shfl_xor(mx, 32));
            const float mn = fmaxf(m[qs], mx);
            const float alpha = __expf(m[qs] - mn);
            m[qs] = mn;
            float ps = 0.f;
            bf16x8 pf;
#pragma unroll
            for (int t = 0; t < 2; ++t)
#pragma unroll
                for (int jj = 0; jj < 4; ++jj) { const float pv = __expf(s[t][jj] - mn); ps += pv; pf[t * 4 + jj] = (short)f2bf(pv); }
            lsum[qs] = lsum[qs] * alpha + ps;
#pragma unroll
            for (int dt = 0; dt < 4; ++dt) {
                o[qs][dt] = o[qs][dt] * alpha;
                o[qs][dt] = __builtin_amdgcn_mfma_f32_16x16x32_bf16(vf[dt], pf, o[qs][dt], 0, 0, 0);
            }
        }
    }
#pragma unroll
    for (int qs = 0; qs < 2; ++qs) {
        float ls = lsum[qs];
        ls += __shfl_xor(ls, 16); ls += __shfl_xor(ls, 32);
        const float inv = 1.0f / ls;
        bf16_t* dst = MIX + (size_t)(rowbase + q0 + qs * 16 + fr) * 1024 + h * 64;
#pragma unroll
        for (int dt = 0; dt < 4; ++dt) {
            uint2 w; w.x = pack2(o[qs][dt][0] * inv, o[qs][dt][1] * inv); w.y = pack2(o[qs][dt][2] * inv, o[qs][dt][3] * inv);
            *(uint2*)(dst + dt * 16 + fq * 4) = w;
        }
    }
}

DEV float fast_tanh(float u) { const float e = __expf(2.0f * u); return 1.0f - 2.0f / (e + 1.0f); }
DEV float gelu_fast(float x) { const float u = 0.7978845608028654f * (x + 0.044715f * x * x * x); return 0.5f * x * (1.0f + fast_tanh(u)); }
DEV float bf2f(bf16_t v) { return __uint_as_float((unsigned)v << 16); }
template <int NCH>
DEV void lru_unit(const Params& p, int jl, int latent, int b, int hb, int coff, unsigned char* lds, int dsel  ) {
    unsigned char* ws = p.ws;
    const float* P = (const float*)(ws + OFF_P);
    float* HF = (float*)(ws + OFF_HU);
    bf16_t* MIX = (bf16_t*)(ws + OFF_MIX);
    constexpr int NT = NCH / 16, AS = NCH + 4;
    const int tid = TIDX, lane = tid & 63, wid = tid >> 6, fr = lane & 15, fq = lane >> 4;
    const int L = latent ? 1024 : 256, rowbase = latent ? MCTX + b * 1024 : b * 256;
    unsigned char* XCb = lds;
    unsigned char* WT0 = lds + 16384;
    float* Al = (float*)(lds + 32768);
    float* Ul = (float*)(lds + 32768 + 17408);
    float* CN0 = (float*)(lds + 32768 + 2 * 17408);
    const int ch0 = hb * 64;
    const float* cw = p.in[17] + jl * 4 * 512; const float* cb = p.in[18] + jl * 512;
    const int sw = (fr >> 1) & 7;
    float* HB = HF + (size_t)MROWS * 512;
    static_assert(NCH <= 32, "two per-direction gate-weight images of 2*NCH rows must fit the 16 KB WT region");
    __syncthreads();
    for (int dir = (dsel < 0 ? 0 : dsel); dir < (dsel < 0 ? 2 : dsel + 1); ++dir) {
        const float* wr_ = p.in[19] + ((size_t)((jl * 2 + dir) * 8 + hb)) * 4096;
        const float* wi_ = p.in[21] + ((size_t)((jl * 2 + dir) * 8 + hb)) * 4096;
        unsigned char* WTd = WT0 + dir * 8192; float* CNd = CN0 + dir * 3 * NCH;
        for (int i = tid; i < 64 * 2 * NCH; i += 256) {
            const int ii = i / (2 * NCH), o = i % (2 * NCH);
            const float wv = o < NCH ? wr_[ii * 64 + coff + o] : wi_[ii * 64 + coff + o - NCH];
            *(bf16_t*)(WTd + o * 128 + ((((ii >> 3) ^ ((o >> 1) & 7))) << 4) + (ii & 7) * 2) = f2bf(wv);
        }
        if (tid < NCH) {
            const int c = (jl * 2 + dir) * 512 + ch0 + coff + tid;
            CNd[tid] = p.in[20][c]; CNd[NCH + tid] = p.in[22][c];
            const float lam = p.in[23][c];
            CNd[2 * NCH + tid] = fmaxf(-lam, 0.f) + log1pf(expf(-fabsf(lam)));
        }
    }
    for (int dir = (dsel < 0 ? 0 : dsel); dir < (dsel < 0 ? 2 : dsel + 1); ++dir) {
        const unsigned char* WT = WT0 + dir * 8192; const float* CN = CN0 + dir * 3 * NCH;
        float hstate = 0.f;
        if (latent && tid < NCH) hstate = p.in[5][((size_t)(b * 2 + jl) * 2 + dir) * 512 + ch0 + coff + tid];
        const int nsc = L / 128;
        const int c4 = (tid & 15) * 4, tk0 = (tid >> 4) * 8;
        f32x4 rows[11];
        {
            const int t0f = (dir == 0 ? 0 : nsc - 1) * 128;
#pragma unroll
            for (int r = 0; r < 11; ++r) {
                const int tt = t0f + tk0 + r - 2, ttc = tt < 0 ? 0 : (tt >= L ? L - 1 : tt);
                const f32x4 v = *(const f32x4*)(P + (size_t)(rowbase + ttc) * 2048 + 768 + ch0 + c4);
                rows[r] = (tt >= 0 && tt < L) ? v : (f32x4){0.f, 0.f, 0.f, 0.f};
            }
        }
        for (int sci = 0; sci < nsc; ++sci) {
            const int t0 = (dir == 0 ? sci : nsc - 1 - sci) * 128;
            __syncthreads();
            {
                const f32x4 cbv = *(const f32x4*)(cb + ch0 + c4);
                f32x4 cwv[4];
#pragma unroll
                for (int k = 0; k < 4; ++k) cwv[k] = *(const f32x4*)(cw + k * 512 + ch0 + c4);
#pragma unroll
                for (int i = 0; i < 8; ++i) {
                    f32x4 sacc = cbv;
#pragma unroll
                    for (int k = 0; k < 4; ++k) sacc = sacc + cwv[k] * rows[i + k];
                    const int tok = tk0 + i;
                    uint2 w; w.x = pack2(sacc[0], sacc[1]); w.y = pack2(sacc[2], sacc[3]);
                    *(uint2*)(XCb + tok * 128 + ((((c4 >> 3) ^ ((tok >> 1) & 7))) << 4) + (c4 & 7) * 2) = w;
                }
                {
                    const int scn = sci + 1 < nsc ? sci + 1 : sci;
                    const int t0n = (dir == 0 ? scn : nsc - 1 - scn) * 128;
#pragma unroll
                    for (int r = 0; r < 11; ++r) {
                        const int tt = t0n + tk0 + r - 2, ttc = tt < 0 ? 0 : (tt >= L ? L - 1 : tt);
                        const f32x4 v = *(const f32x4*)(P + (size_t)(rowbase + ttc) * 2048 + 768 + ch0 + c4);
                        rows[r] = (tt >= 0 && tt < L) ? v : (f32x4){0.f, 0.f, 0.f, 0.f};
                    }
                }
            }
            __syncthreads();
            for (int sbi = 0; sbi < 2; ++sbi) {
                const int sub = dir == 0 ? sbi : 1 - sbi;
                float gpre[16 * NCH / 64], hpre[16 * NCH / 64];
                if (dir == 1 && dsel < 0) {
#pragma unroll
                    for (int k = 0; k < 16 * NCH / 64; ++k) {
                        const int i = tid + 256 * k, tok = i / NCH, cch = ch0 + coff + (i % NCH);
                        const size_t row = rowbase + t0 + sub * 64 + tok;
                        gpre[k] = P[row * 2048 + 1280 + cch]; hpre[k] = HF[row * 512 + cch];
                    }
                }
                f32x4 acc[2 * NT];
#pragma unroll
                for (int i = 0; i < 2 * NT; ++i) acc[i] = (f32x4){0.f, 0.f, 0.f, 0.f};
                const int trow = sub * 64 + wid * 16 + fr;
#pragma unroll
                for (int ks = 0; ks < 2; ++ks) {
                    const int chk = ((ks * 4 + fq) ^ sw) << 4;
                    const bf16x8 af = *(const bf16x8*)(XCb + trow * 128 + chk);
#pragma unroll
                    for (int ni = 0; ni < 2 * NT; ++ni) {
                        const bf16x8 bfr = *(const bf16x8*)(WT + (ni * 16 + fr) * 128 + chk);
                        acc[ni] = __builtin_amdgcn_mfma_f32_16x16x32_bf16(bfr, af, acc[ni], 0, 0, 0);
                    }
                }
                __syncthreads();
#pragma unroll
                for (int nc = 0; nc < NT; ++nc) {
                    const int cl = nc * 16 + fq * 4;
                    const int cc = coff + cl;
                    const f32x4 brv = *(const f32x4*)(CN + cl), biv = *(const f32x4*)(CN + NCH + cl), spv = *(const f32x4*)(CN + 2 * NCH + cl);
                    const uint2 xw = *(const uint2*)(XCb + trow * 128 + ((((cc >> 3) ^ ((trow >> 1) & 7))) << 4) + (cc & 7) * 2);
                    const float xv[4] = {__uint_as_float(xw.x << 16), __uint_as_float(xw.x & 0xffff0000u), __uint_as_float(xw.y << 16), __uint_as_float(xw.y & 0xffff0000u)};
                    f32x4 av, uv;
#pragma unroll
                    for (int jj = 0; jj < 4; ++jj) {
                        const float r = sigmoidf_(acc[nc][jj] + brv[jj]), gi = sigmoidf_(acc[NT + nc][jj] + biv[jj]);
                        const float la = -8.0f * r * spv[jj];
                        const float aa = __expf(la);
                        av[jj] = aa;
                        uv[jj] = sqrtf(fmaxf(1.0f - aa * aa, 0.f)) * gi * xv[jj];
                    }
                    *(f32x4*)(Al + (wid * 16 + fr) * AS + cl) = av;
                    *(f32x4*)(Ul + (wid * 16 + fr) * AS + cl) = uv;
                }
                __syncthreads();
                if (tid < NCH) {
                    for (int s8 = 0; s8 < 64; s8 += 8) {
                        float a8[8], u8[8];
#pragma unroll
                        for (int e = 0; e < 8; ++e) { const int tok = dir == 0 ? s8 + e : 63 - (s8 + e); a8[e] = Al[tok * AS + tid]; u8[e] = Ul[tok * AS + tid]; }
#pragma unroll
                        for (int e = 0; e < 8; ++e) { hstate = a8[e] * hstate + u8[e]; u8[e] = hstate; }
#pragma unroll
                        for (int e = 0; e < 8; ++e) { const int tok = dir == 0 ? s8 + e : 63 - (s8 + e); Ul[tok * AS + tid] = u8[e]; }
                    }
                }
                __syncthreads();
#pragma unroll
                for (int k = 0; k < 16 * NCH / 64; ++k) {
                    const int i = tid + 256 * k;
                    const int tok = i / NCH, cl = i % NCH, cch = ch0 + coff + cl;
                    const size_t row = rowbase + t0 + sub * 64 + tok;
                    const float hv = Ul[tok * AS + cl];
                    if (dir == 0) HF[row * 512 + cch] = hv;
                    else if (dsel >= 0) HB[row * 512 + cch] = hv;
                    else MIX[row * 1024 + 512 + cch] = f2bf((hpre[k] + hv) * gelu_fast(gpre[k]));
                }
            }
        }
        if (!latent && tid < NCH) p.out[OUT_LRU + ((size_t)(b * 2 + jl) * 2 + dir) * 512 + ch0 + coff + tid] = hstate;
    }
    if (dsel >= 0) {
        volatile int* slot = (volatile int*)(lds + LDS_BYTES - 28);
        unsigned* cnt = (unsigned*)(ws + OFF_CTL + 14336 + 256) + jl * 64 + ((b * 8 + hb) * (64 / NCH) + coff / NCH);
        asm volatile("s_waitcnt vmcnt(0)" ::: "memory");
        __syncthreads();
        if (tid == 0) {
            __builtin_amdgcn_fence(__ATOMIC_RELEASE, "agent");
            asm volatile("s_waitcnt vmcnt(0)" ::: "memory");
            const unsigned old = __hip_atomic_fetch_add(cnt, 1u, __ATOMIC_RELAXED, __HIP_MEMORY_SCOPE_AGENT);
            __builtin_amdgcn_fence(__ATOMIC_ACQUIRE, "agent");
            asm volatile("s_waitcnt vmcnt(0)" ::: "memory");
            *slot = (int)old;
        }
        __syncthreads();
        if (*slot == 1) {
            for (int i = tid; i < L * NCH; i += 256) {
                const int tok = i / NCH, cch = ch0 + coff + (i % NCH);
                const size_t row = rowbase + tok;
                const float gg = P[row * 2048 + 1280 + cch];
                MIX[row * 1024 + 512 + cch] = f2bf((HF[row * 512 + cch] + HB[row * 512 + cch]) * gelu_fast(gg));
            }
        }
    }
}

DEV void phase_even_mixer(const Params& p, int l, unsigned char* lds, unsigned* ctr) {
    const int jl = l >> 1;
    for (;;) {
        const int u = wq_next(ctr, lds);
        if (u >= (l == 0 ? 1280 + 256 + 348 : 1280)) break;
        if (u >= 1536) { sw_unit(p, u - 1536 + 28, lds); continue; }
        if (u >= 1280) { filter_unit(p, u - 1280, lds); continue; }
        if (u < 128) lru_unit<16>(p, jl, 1, u >> 6, (u >> 3) & 7, ((u >> 1) & 3) * 16, lds, u & 1);
        else if (u < 256) { const int uu = u - 128; attn_unit(p, jl, 1, uu >> 6, (uu >> 5) & 1, uu & 31, lds); }
        else if (u < 768) { const int uu = u - 256; lru_unit<32>(p, jl, 0, uu >> 4, (uu >> 1) & 7, (uu & 1) * 32, lds, -1); }
        else { const int uu = u - 768; attn_unit(p, jl, 0, uu >> 4, (uu >> 3) & 1, uu & 7, lds); }
    }
}

template <int L, int NBAT>
DEV void hyena_unit(const Params& p, int j, int c, int bg, unsigned char* lds) {
    unsigned char* ws = p.ws;
    constexpr int LAT = (L == 1024) ? 1 : 0;
    constexpr int MIW = LAT ? 2 : L / 64, ZS = LAT ? 2576 : 2 * L + 16, ZOFF = LAT ? 256 : 0, FS = LAT ? 4416 : 4 * L + 64  ;
    constexpr int CHK = LAT ? 264 : L / 4  , NKS = LAT ? 36 : L / 32, MSTEP = LAT ? 128 : 16;
    const int tid = TIDX, lane = tid & 63, wid = tid >> 6, fr = lane & 15, fq = lane >> 4;
    unsigned char* Zb = lds; unsigned char* X1b = Zb + NBAT * ZS; unsigned char* X2b = X1b + NBAT * ZS; unsigned char* FC = X2b + NBAT * ZS;
    const int rowbase0 = LAT ? MCTX : bg * 16 * 256;
    const bf16_t* PT = (const bf16_t*)(ws + OFF_HU);
    const float* TFb = (const float*)(ws + OFF_TF + (size_t)j * 10 * MiB + (LAT ? 2 * MiB : 0));
    const float* cw = p.in[26] + j * 3 * 1536; const float* cb = p.in[27] + j * 1536;
    __syncthreads();
    float* STG = (float*)(FC + (size_t)(LAT ? 1 : 2) * 8 * FS);
    auto stage = [&](int n, int sslot) {
        const float* Rv = TFb + ((size_t)n * 512 + c) * (2 * L);
        const float rsn = ((const float*)(ws + OFF_HID + 655360))[((j * 2 + LAT) * 2 + n) * 512 + c];
        for (int i = tid; i < 2 * L / 4; i += 256) *(f32x4*)(STG + sslot * 2 * L + i * 4) = *(const f32x4*)(Rv + i * 4) * rsn;
    };
    auto build = [&](int sslot, int slot) {
        const float* R = STG + sslot * 2 * L;
        for (int q = tid; q < 8 * CHK; q += 256) {
            const int sft = q / CHK, x = (q % CHK) * 8;
            float v[8];
#pragma unroll
            for (int e = 0; e < 8; ++e) { const int y = x + sft + e; const float rvv = R[y < 2 * L ? y : 2 * L - 1]; v[e] = y < 2 * L ? rvv : 0.f; }
            u32x4 w; w.x = pack2(v[0], v[1]); w.y = pack2(v[2], v[3]); w.z = pack2(v[4], v[5]); w.w = pack2(v[6], v[7]);
            *(u32x4*)(FC + (size_t)slot * 8 * FS + sft * FS + x * 2) = w;
        }
    };
    if (LAT && tid < 64) {
        const int zr = tid >> 5, side = (tid >> 4) & 1, off = (tid & 15) * 16;
        const unsigned z0 = (unsigned)tid >> 31;
        *(u32x4*)(Zb + zr * ZS + (side ? ZOFF + 2 * L : 0) + off) = (u32x4){z0, z0, z0, z0};
    }
    stage(0, 0);
    stage(1, 1);
    __syncthreads();
    build(0, 0);
    if (!LAT) build(1, 1);
#pragma unroll
    for (int st = 0; st < 3; ++st) {
        const int ch3 = st * 512 + c;
        const float w0 = cw[ch3], w1 = cw[1536 + ch3], w2 = cw[2 * 1536 + ch3], bb0 = cb[ch3];
        unsigned char* dstb = st == 0 ? Zb : (st == 1 ? X1b : X2b);
        for (int q = tid; q < NBAT * L / 8; q += 256) {
            const int bb = q / (L / 8), t0 = (q % (L / 8)) * 8;
            const bf16_t* src = PT + (size_t)ch3 * MROWS + rowbase0 + bb * L + t0;
            const u32x4 raw = __builtin_nontemporal_load((const u32x4*)src);
            float x[10];
            { const bf16_t pv = src[t0 > 0 ? -1 : 0], nv = src[t0 + 8 < L ? 8 : 7]; x[0] = t0 > 0 ? bf2f(pv) : 0.f; x[9] = t0 + 8 < L ? bf2f(nv) : 0.f; }
            x[1] = __uint_as_float(raw.x << 16); x[2] = __uint_as_float(raw.x & 0xffff0000u);
            x[3] = __uint_as_float(raw.y << 16); x[4] = __uint_as_float(raw.y & 0xffff0000u);
            x[5] = __uint_as_float(raw.z << 16); x[6] = __uint_as_float(raw.z & 0xffff0000u);
            x[7] = __uint_as_float(raw.w << 16); x[8] = __uint_as_float(raw.w & 0xffff0000u);
            float o[8];
#pragma unroll
            for (int e = 0; e < 8; ++e) o[e] = bb0 + w0 * x[e] + w1 * x[e + 1] + w2 * x[e + 2];
            u32x4 w; w.x = pack2(o[0], o[1]); w.y = pack2(o[2], o[3]); w.z = pack2(o[4], o[5]); w.w = pack2(o[6], o[7]);
            *(u32x4*)(dstb + bb * ZS + ZOFF + t0 * 2) = w;
        }
    }
    __syncthreads();
    const int brow = NBAT == 16 ? fr : (fr & 1);
    const int sft = 7 - (fr & 7);
    bf16_t* ZT = (bf16_t*)(ws + OFF_XG);
#pragma unroll
    for (int ord = 0; ord < 2; ++ord) {
        const unsigned char* FCn = FC + (size_t)(LAT ? 0 : ord) * 8 * FS + sft * FS;
        f32x4 acc[MIW];
#pragma unroll
        for (int mi = 0; mi < MIW; ++mi) acc[mi] = (f32x4){0.f, 0.f, 0.f, 0.f};
        const int i00 = LAT ? 112 + wid * MIW * MSTEP : wid * MIW * MSTEP;
        const unsigned char* abase = FCn + (L - 8 - i00 - (fr & 8) + fq * 8) * 2;
        const unsigned char* bbase = LAT ? Zb + (fr >> 3) * ZS + ZOFF + (fq * 8 - 16 * (fr & 7)) * 2 : Zb + brow * ZS + fq * 16;
#pragma unroll 2
        for (int ks = 0; ks < NKS; ++ks) {
            const bf16x8 bfrag = *(const bf16x8*)(bbase + ks * 64);
            bf16x8 af[MIW];
#pragma unroll
            for (int mi = 0; mi < MIW; ++mi) af[mi] = *(const bf16x8*)(abase + ks * 64 - mi * MSTEP * 2);
#pragma unroll
            for (int mi = 0; mi < MIW; ++mi) acc[mi] = __builtin_amdgcn_mfma_f32_16x16x32_bf16(af[mi], bfrag, acc[mi], 0, 0, 0);
            __builtin_amdgcn_sched_group_barrier(0x100, MIW + 1, 0);
            __builtin_amdgcn_sched_group_barrier(0x008, MIW, 0);
        }
        const float hb = p.in[35][(j * 2 + ord) * 512 + c];
        if (ord == 0) {
            __syncthreads();
            {
                const int eb = LAT ? (fr >> 3) : fr;
#pragma unroll
                for (int mi = 0; mi < MIW; ++mi) {
                    const int t = i00 + mi * MSTEP + fq * 4 - (LAT ? 16 * (fr & 7) : 0);
                    const uint2 zr = *(const uint2*)(Zb + eb * ZS + ZOFF + t * 2), xr = *(const uint2*)(X1b + eb * ZS + ZOFF + t * 2);
                    const float z[4] = {__uint_as_float(zr.x << 16), __uint_as_float(zr.x & 0xffff0000u), __uint_as_float(zr.y << 16), __uint_as_float(zr.y & 0xffff0000u)};
                    const float g[4] = {__uint_as_float(xr.x << 16), __uint_as_float(xr.x & 0xffff0000u), __uint_as_float(xr.y << 16), __uint_as_float(xr.y & 0xffff0000u)};
                    float o[4];
#pragma unroll
                    for (int e = 0; e < 4; ++e) o[e] = g[e] * (acc[mi][e] + hb * z[e]);
                    uint2 w; w.x = pack2(o[0], o[1]); w.y = pack2(o[2], o[3]);
                    *(uint2*)(Zb + eb * ZS + ZOFF + t * 2) = w;
                }
            }
            if (LAT) build(1, 0);
            __syncthreads();
        } else {
            {
                const int eb = LAT ? (fr >> 3) : fr;
#pragma unroll
                for (int mi = 0; mi < MIW; ++mi) {
                    const int t = i00 + mi * MSTEP + fq * 4 - (LAT ? 16 * (fr & 7) : 0);
                    const uint2 zr = *(const uint2*)(Zb + eb * ZS + ZOFF + t * 2), xr = *(const uint2*)(X2b + eb * ZS + ZOFF + t * 2);
                    const float z[4] = {__uint_as_float(zr.x << 16), __uint_as_float(zr.x & 0xffff0000u), __uint_as_float(zr.y << 16), __uint_as_float(zr.y & 0xffff0000u)};
                    const float g[4] = {__uint_as_float(xr.x << 16), __uint_as_float(xr.x & 0xffff0000u), __uint_as_float(xr.y << 16), __uint_as_float(xr.y & 0xffff0000u)};
                    float o[4];
#pragma unroll
                    for (int e = 0; e < 4; ++e) o[e] = g[e] * (acc[mi][e] + hb * z[e]);
                    uint2 w; w.x = pack2(o[0], o[1]); w.y = pack2(o[2], o[3]);
                    *(uint2*)(ZT + (size_t)c * MROWS + rowbase0 + eb * L + t) = w;
                }
            }
        }
    }
}

DEV void phase_odd1(const Params& p, int l, unsigned char* lds, unsigned* ctr) {
    unsigned char* ws = p.ws;
    const int j = l >> 1;
    for (;;) {
        const int u = wq_next(ctr, lds);
        if (u >= 2176) break;
        if (u < 512) { hyena_unit<1024, 2>(p, j, u, 0, lds); if (REP(13) > 1) hyena_unit<1024, 2>(p, j, u, 0, lds); }
        else if (u < 1536) { const int uu = u - 512; hyena_unit<256, 16>(p, j, uu >> 1, uu & 1, lds); if (REP(14) > 1) hyena_unit<256, 16>(p, j, uu >> 1, uu & 1, lds); }
        else {
            int latent, b, g, tm, tn, L;
            if (u < 1664) { const int uu = u - 1536; latent = 1; L = 1024; b = uu >> 6; g = (uu >> 4) & 3; tm = (uu >> 3) & 1; tn = uu & 7; }
            else { const int uu = u - 1664; latent = 0; L = 256; b = uu >> 4; g = (uu >> 2) & 3; tm = (uu >> 1) & 1; tn = uu & 1; }
            const int rowbase = latent ? MCTX + b * 1024 : b * 256;
            EpiF1 epi; epi.L = L; epi.g = g;
            epi.FT = (bf16_t*)(ws + OFF_FT) + (latent ? (size_t)32 * 512 * 512 + (size_t)b * 512 * 2048 : (size_t)b * 512 * 512);
            __syncthreads();
            gemm_tile<128>((const bf16_t*)(ws + OFF_CS128), 128, (const bf16_t*)(ws + OFF_PF) + (size_t)rowbase * 512 + g * 128, 512, 128, tm * 128, tn * 128, lds, epi);
        }
    }
}
DEV void phase_odd2(const Params& p, int l, unsigned char* lds, int vb, int G) {
    unsigned char* ws = p.ws;
    for (int it = 0;; ++it) {
        int u;
        if (G == 512) {
            if (it == 0) { if (vb >= 384) continue; u = vb; }
            else { const int ux = (vb - 128) + (it - 1) * 384; if (vb < 128 || ux >= 1280) break; u = 384 + ux; }
        } else { u = vb + it * G; if (u >= 1664) break; }
        if (u >= 384) {
            const int uu = u - 384, c0 = (uu & 7) * 64, r0 = (uu >> 3) * 64;
            const int tid = TIDX;
            const bf16_t* ZT = (const bf16_t*)(ws + OFF_XG);
            bf16_t* MIXp = (bf16_t*)(ws + OFF_MIX);
            __syncthreads();
            {
                const int cc = tid >> 2, part = tid & 3;
                const u32x4* src = (const u32x4*)(ZT + (size_t)(c0 + cc) * MROWS + r0 + part * 16);
                const u32x4 a0 = src[0], a1 = src[1];
                *(u32x4*)(lds + cc * 144 + part * 32) = a0;
                *(u32x4*)(lds + cc * 144 + part * 32 + 16) = a1;
            }
            __syncthreads();
            {
                const int rr = tid >> 2, part = tid & 3;
                unsigned w[8];
#pragma unroll
                for (int e = 0; e < 8; ++e) {
                    const unsigned lo = *(const bf16_t*)(lds + (part * 16 + 2 * e) * 144 + rr * 2);
                    const unsigned hi = *(const bf16_t*)(lds + (part * 16 + 2 * e + 1) * 144 + rr * 2);
                    w[e] = lo | (hi << 16);
                }
                u32x4* dst = (u32x4*)(MIXp + (size_t)(r0 + rr) * 1024 + 512 + c0 + part * 16);
                dst[0] = (u32x4){w[0], w[1], w[2], w[3]};
                dst[1] = (u32x4){w[4], w[5], w[6], w[7]};
            }
            continue;
        }
        if (u < 128) {
            const int b = u >> 6, tm = (u >> 3) & 7, tn = u & 7;
            EpiF2 epi; epi.MIX = (bf16_t*)(ws + OFF_MIX); epi.rowbase = MCTX + b * 1024;
            __syncthreads();
            gemm_tile<64>((const bf16_t*)(ws + OFF_CSL1024), 2048, (const bf16_t*)(ws + OFF_FT) + (size_t)32 * 512 * 512 + (size_t)b * 512 * 2048, 2048, 2048, tm * 128, tn * 64, lds, epi);
        } else {
            const int uu = u - 128, b = uu >> 3, tm = (uu >> 2) & 1, tn = uu & 3;
            EpiF2 epi; epi.MIX = (bf16_t*)(ws + OFF_MIX); epi.rowbase = b * 256;
            __syncthreads();
            gemm_tile<128>((const bf16_t*)(ws + OFF_CSL256), 512, (const bf16_t*)(ws + OFF_FT) + (size_t)b * 512 * 512, 512, 512, tm * 128, tn * 128, lds, epi);
        }
    }
}

DEV void phase_final(const Params& p, int vb, int G) {
    unsigned char* ws = p.ws;
    const float* X = (const float*)(ws + OFF_X);
    const float* SSQ = (const float*)(ws + OFF_SSQ) + (size_t)8 * 16 * MROWS;
    const int lane = TIDX & 63;
    for (int u = vb; u < 640; u += G) {
        const int r0 = u * 16 + (TIDX >> 6) * 4;
        for (int rr = 0; rr < 4; ++rr) {
            const int row = r0 + rr;
            float s = lane < 16 ? SSQ[(size_t)lane * MROWS + row] : 0.f;
#pragma unroll
            for (int o = 8; o >= 1; o >>= 1) s += __shfl_xor(s, o);
            s = __shfl(s, 0);
            const float rs = rsqrtf(s * (1.0f / 1024.0f) + 1e-6f);
#pragma unroll
            for (int i = 0; i < 4; ++i) {
                const int col = lane * 4 + i * 256;
                const f32x4 x = *(const f32x4*)(X + (size_t)row * 1024 + col);
                const f32x4 w4 = *(const f32x4*)(p.in[11] + col);
                *(f32x4*)(p.out + (size_t)row * 1024 + col) = x * rs * w4;
            }
        }
    }
}


#define XB_TMO      128
#define XB_XCNT(j)  (256  + 64 * (j))
#define XB_XSUB(j)  (1280 + 64 * (j))
#define XB_XGEN(j)  (2304 + 64 * (j))
#define XB_TOP      3328
#define XB_TOPGEN   3392
#define XCD_BAR_WORDS 3456
#define XB_SPIN_CAP (1u << 18)
__device__ __forceinline__ unsigned xb_ld(unsigned* p)              { return __hip_atomic_load(p, __ATOMIC_RELAXED, __HIP_MEMORY_SCOPE_AGENT); }
__device__ __forceinline__ unsigned xb_add(unsigned* p, unsigned v) { return __hip_atomic_fetch_add(p, v, __ATOMIC_RELAXED, __HIP_MEMORY_SCOPE_AGENT); }
__device__ __forceinline__ unsigned xb_xcc_id() { return (unsigned)__builtin_amdgcn_s_getreg((3 << 11) | 20) & 0xFu; }
#define XB_SPIN(cond, bar) do { unsigned _sp = 0; while (cond) { __builtin_amdgcn_s_sleep(0); \
    if ((++_sp & 255u) == 0u) { if (xb_ld(&(bar)[XB_TMO])) break; if (_sp > XB_SPIN_CAP) { atomicAdd(&(bar)[XB_TMO], 1u); break; } } } } while (0)
struct XcdBarrier { unsigned* bar; unsigned x; volatile unsigned* st; };
__device__ __forceinline__ XcdBarrier xcd_barrier_post(unsigned* bar, volatile unsigned* st) {
    XcdBarrier b; b.bar = bar; b.x = xb_xcc_id(); b.st = st;
    if (threadIdx.x == 0) (void)xb_add(&bar[XB_XCNT(b.x)], 1u);
    return b;
}
__device__ __forceinline__ void xcd_barrier_complete(unsigned* bar, unsigned x, unsigned& nloc, unsigned& nx) {
    const unsigned G = gridDim.x * gridDim.y * gridDim.z;
    unsigned sum, cnt, mine, sp = 0u;
    for (;;) {
        sum = 0u; cnt = 0u; mine = 0u;
#pragma unroll
        for (unsigned j = 0; j < 16; ++j) { const unsigned c = xb_ld(&bar[XB_XCNT(j)]); sum += c; cnt += (c > 0u) ? 1u : 0u; mine = (j == x) ? c : mine; }
        if (sum == G) break;
        __builtin_amdgcn_s_sleep(1);
        if ((++sp & 255u) == 0u) { if (xb_ld(&bar[XB_TMO])) break; if (sp > XB_SPIN_CAP) { atomicAdd(&bar[XB_TMO], 1u); break; } }
    }
    nloc = mine > 0u ? mine : 1u; nx = cnt > 0u ? cnt : 1u;
}
__device__ __forceinline__ void xcd_barrier(const XcdBarrier& b) {
    asm volatile("s_waitcnt vmcnt(0)" ::: "memory");
    __syncthreads();
    if (threadIdx.x == 0) {
        unsigned* bar = b.bar;
        __builtin_amdgcn_s_waitcnt(0);
        unsigned nloc = b.st[0], nx = b.st[1];
        if (nloc == 0u) { xcd_barrier_complete(bar, b.x, nloc, nx); b.st[0] = nloc; b.st[1] = nx; }
        const unsigned old = xb_add(&bar[XB_XSUB(b.x)], 1u);
        const unsigned gen = old / nloc;
        if (old + 1u == (gen + 1u) * nloc) {
            __builtin_amdgcn_fence(__ATOMIC_RELEASE, "agent");
            asm volatile("s_waitcnt vmcnt(0)" ::: "memory");
            const unsigned og = xb_add(&bar[XB_TOP], 1u);
            const unsigned tg = og / nx;
            if (og + 1u == (tg + 1u) * nx) xb_add(&bar[XB_TOPGEN], 1u);
            else XB_SPIN(xb_ld(&bar[XB_TOPGEN]) == tg, bar);
            __builtin_amdgcn_fence(__ATOMIC_ACQUIRE, "agent");
            xb_add(&bar[XB_XGEN(b.x)], 1u);
            asm volatile("s_waitcnt vmcnt(0)" ::: "memory");
        } else {
            XB_SPIN(xb_ld(&bar[XB_XGEN(b.x)]) == gen, bar);
            __builtin_amdgcn_fence(__ATOMIC_ACQUIRE, "agent");
            asm volatile("s_waitcnt vmcnt(0)" ::: "memory");
        }
    }
    __syncthreads();
}

#ifndef ONLY
#define ONLY -1
#endif
#define EN(x) (ONLY < 0 || ONLY == (x))
DEV void run_phase(const Params& p, int ph, unsigned char* lds, int vb, int G) {
    if (ph == 0) { if (EN(0)) for (int r_ = 0; r_ < REP(0); ++r_) phase_prepA(p, lds, vb, G); return; }
    if (ph == 1) { if (EN(1)) for (int r_ = 0; r_ < REP(1); ++r_) phase_prepB(p, lds, vb, G); return; }
    if (ph == 24) { if (EN(2)) for (int r_ = 0; r_ < REP(2); ++r_) phase_final(p, vb, G); return; }
    int q = ph - 2, l;
    if (q < 5) l = 0; else if (q < 11) { l = 1; q -= 5; } else if (q < 16) { l = 2; q -= 11; } else { l = 3; q -= 16; }
    if (!(l & 1)) {
        switch (q) {
            case 0: if (EN(3)) for (int r_ = 0; r_ < REP(3); ++r_) phase_gemm_in(p, l, lds, vb, G); break;
            case 1: if (EN(4)) for (int r_ = 0; r_ < REP(4); ++r_) phase_even_mixer(p, l, lds, (unsigned*)(p.ws + OFF_CTL + 16384) + (ph * 2 + r_) * 512); break;
            case 2: if (EN(5)) for (int r_ = 0; r_ < REP(11); ++r_) phase_gemm_res(p, l, 0, lds, vb, G, r_ ? 0.f : 1.f); break;
            case 3: if (EN(6)) for (int r_ = 0; r_ < REP(6); ++r_) phase_gemm_mlp1(p, l, lds, vb, G); break;
            default: if (EN(5)) for (int r_ = 0; r_ < REP(12); ++r_) phase_gemm_res(p, l, 1, lds, vb, G, r_ ? 0.f : 1.f); break;
        }
    } else {
        switch (q) {
            case 0: if (EN(3)) for (int r_ = 0; r_ < REP(3); ++r_) phase_gemm_in(p, l, lds, vb, G); break;
            case 1: if (EN(7)) for (int r_ = 0; r_ < REP(7); ++r_) phase_odd1(p, l, lds, (unsigned*)(p.ws + OFF_CTL + 16384) + (ph * 2 + r_) * 512); break;
            case 2: if (EN(8)) for (int r_ = 0; r_ < REP(8); ++r_) phase_odd2(p, l, lds, vb, G); break;
            case 3: if (EN(5)) for (int r_ = 0; r_ < REP(11); ++r_) phase_gemm_res(p, l, 0, lds, vb, G, r_ ? 0.f : 1.f); break;
            case 4: if (EN(6)) for (int r_ = 0; r_ < REP(6); ++r_) phase_gemm_mlp1(p, l, lds, vb, G); break;
            default: if (EN(5)) for (int r_ = 0; r_ < REP(12); ++r_) phase_gemm_res(p, l, 1, lds, vb, G, r_ ? 0.f : 1.f); break;
        }
    }
}

__global__ void __launch_bounds__(256, 2) hybrid_fwd(Params p, int ph_lo, int ph_hi) {
    extern __shared__ __attribute__((aligned(16))) unsigned char lds[];
    const int G = gridDim.x;
    const int vb = (G & 7) == 0 ? (blockIdx.x & 7) * (G >> 3) + (blockIdx.x >> 3) : blockIdx.x;
#if N_LAUNCH_SPLIT
    for (int ph = ph_lo; ph < ph_hi; ++ph) run_phase(p, ph, lds, vb, G);
#else
    cg::grid_group grid = cg::this_grid();
    volatile unsigned* st = (volatile unsigned*)(lds + LDS_BYTES - 16);
    if (threadIdx.x == 0) { st[0] = 0u; st[1] = 0u; }
    __syncthreads();
    XcdBarrier xb = xcd_barrier_post((unsigned*)(p.ws + OFF_CTL), st);
    if (ph_lo < 0) grid.sync();
    for (int ph = ph_lo; ph < ph_hi; ++ph) {
        run_phase(p, ph, lds, vb, G);
        if (ph + 1 < ph_hi) { xcd_barrier(xb); for (int r_ = 1; r_ < REP(10); ++r_) xcd_barrier(xb); }
    }
#endif
}

extern "C" void kernel_launch(void* const* d_in, const int* in_sizes, int n_in, void* d_out, int out_size, void* d_ws, size_t ws_size, hipStream_t stream) {
    static int grid = 0;
    if (grid == 0) {
        if (n_in != 36 || ws_size < WS_END) { fprintf(stderr, "kernel_launch: need 36 inputs and >= %zu bytes of workspace (got %d, %zu)\n", (size_t)WS_END, n_in, ws_size); grid = -1; return; }
        int dev = 0, cus = 0, per_cu = 0;
        hipGetDevice(&dev);
        hipDeviceGetAttribute(&cus, hipDeviceAttributeMultiprocessorCount, dev);
        hipFuncSetAttribute((const void*)hybrid_fwd, hipFuncAttributeMaxDynamicSharedMemorySize, LDS_BYTES);
        hipOccupancyMaxActiveBlocksPerMultiprocessor(&per_cu, (const void*)hybrid_fwd, 256, LDS_BYTES);
        if (per_cu < 1) per_cu = 1;
        if (per_cu > 2) per_cu = 2;
        grid = cus * per_cu;
        fprintf(stderr, "kernel_launch: grid %d (%d CUs x %d)\n", grid, cus, per_cu);
    }
    if (grid < 0) return;
    Params p{};
    for (int i = 0; i < 36; ++i) p.in[i] = (const float*)d_in[i];
    p.out = (float*)d_out; p.ws = (unsigned char*)d_ws;
#if N_LAUNCH_SPLIT
    for (int ph = 0; ph < NPHASE; ++ph) hipLaunchKernelGGL(hybrid_fwd, dim3(grid), dim3(256), LDS_BYTES, stream, p, ph, ph + 1);
#else
    if (hipMemsetAsync((char*)d_ws + OFF_CTL, 0, CTL_BYTES, stream) != hipSuccess) { fprintf(stderr, "kernel_launch: memset of control words failed\n"); return; }
    int lo = 0, hi = NPHASE;
    void* args[] = {&p, &lo, &hi};
    hipError_t e = hipLaunchCooperativeKernel((const void*)hybrid_fwd, dim3(grid), dim3(256), args, LDS_BYTES, stream);
    if (e != hipSuccess) fprintf(stderr, "cooperative launch failed: %s (grid %d)\n", hipGetErrorString(e), grid);
#endif
}
```
